# Optimizing an MI355X kernel written in HIP

```python
import math
import jax, jax.numpy as jnp
from jax import lax
import numpy as np

D_MODEL = 1024
BATCH = 32
SEQ = 256
DEPTH = 2
DEC_BATCH = 8
DEC_SEQ = 4096
PAST_LEN = 512

GRID_W = 64
N_EVEN = (DEPTH + 1) // 2
N_ODD = DEPTH // 2
RET_HEADS = 4
RET_DK = 128
RET_DV = 128
RET_WIDTH = RET_HEADS * RET_DV
RET_CHUNK = 128
ROPE_BASE = 10000.0
CONV_WIDTH = D_MODEL // 2
CONV_K = 3
AB_IN = 3 * RET_HEADS * RET_DK + RET_WIDTH + 3 * CONV_WIDTH
AB_IN = 2 * RET_HEADS * RET_DK + 2 * RET_WIDTH + 3 * CONV_WIDTH
AB_OUT = RET_WIDTH + CONV_WIDTH
CMLP_WIDTH = D_MODEL
CMLP_GROUPS = 4
CMLP_CHUNK = 128
FFN_HIDDEN = ((8 * D_MODEL // 3 + 255) // 256) * 256
EPS = 1e-6

kernel_name = 'hybrid_retention_conv_chunkmlp_diffusion_step'


def _rmsnorm(x, g):
    x32 = x.astype(jnp.float32)
    y = x32 * lax.rsqrt(jnp.mean(x32 * x32, axis=-1, keepdims=True) + EPS)
    return (y * g.astype(jnp.float32)).astype(x.dtype)


def _rope_2d(T):
    rows = T // GRID_W
    row = jnp.repeat(jnp.arange(rows, dtype=jnp.float32), GRID_W)
    col = jnp.tile(jnp.arange(GRID_W, dtype=jnp.float32), rows)
    nf = RET_DK // 4
    freqs = ROPE_BASE ** (-jnp.arange(nf, dtype=jnp.float32) / nf)
    ang = jnp.concatenate([row[:, None] * freqs, col[:, None] * freqs], axis=-1)
    return jnp.cos(ang)[:, None, :], jnp.sin(ang)[:, None, :]


def _apply_rope(x, cos, sin):
    half = x.shape[-1] // 2
    x1, x2 = x[..., :half], x[..., half:]
    cos = cos.astype(x.dtype)
    sin = sin.astype(x.dtype)
    return jnp.concatenate([x1 * cos - x2 * sin, x2 * cos + x1 * sin], axis=-1)


def _retention_scan(q, k, v, log_gamma, S0):
    B, T, H, DK = q.shape
    DV = v.shape[-1]
    n = T // RET_CHUNK
    dt = q.dtype

    def to_chunks(a):
        return a.reshape(B, n, RET_CHUNK, H, a.shape[-1]).transpose(1, 0, 3, 2, 4)

    qc, kc, vc = to_chunks(q), to_chunks(k), to_chunks(v)
    idx = jnp.arange(RET_CHUNK, dtype=jnp.float32)
    diff = idx[:, None] - idx[None, :]
    lg = log_gamma[:, None, None]
    dmask = jnp.where(diff >= 0, jnp.exp(jnp.maximum(diff, 0.0) * lg), 0.0).astype(dt)
    cross = jnp.exp((idx + 1.0) * log_gamma[:, None]).astype(dt)[..., None]
    kdec = jnp.exp((RET_CHUNK - 1.0 - idx) * log_gamma[:, None]).astype(dt)[..., None]
    chunk_dec = jnp.exp(RET_CHUNK * log_gamma).astype(dt)[:, None, None]

    def step(S, inp):
        qb, kb, vb = inp
        scores = jnp.einsum('bhid,bhjd->bhij', qb, kb) * dmask
        o = jnp.einsum('bhij,bhjv->bhiv', scores, vb) + jnp.einsum('bhid,bhdv->bhiv', qb, S) * cross
        S_new = S * chunk_dec + jnp.einsum('bhjd,bhjv->bhdv', kb * kdec, vb)
        return S_new, o

    S_fin, o = lax.scan(step, S0.astype(dt), (qc, kc, vc))
    o = o.transpose(1, 0, 3, 2, 4).reshape(B, T, H, DV)
    return o, S_fin


def _short_conv(x, w, b):
    xp = jnp.pad(x, ((0, 0), (1, 1), (0, 0)))
    return w[0] * xp[:, :-2] + w[1] * xp[:, 1:-1] + w[2] * xp[:, 2:] + b


def _mixer_ab(h, w_in, decay_logit, ret_g, conv_w, conv_b, w_out, S0, use_rope):
    B, T, _ = h.shape
    p = h @ w_in
    qd = RET_HEADS * RET_DK
    splits = np.cumsum([qd, qd, RET_WIDTH, RET_WIDTH, CONV_WIDTH, CONV_WIDTH])
    q, k, v, g, bg, cg, xc = jnp.split(p, splits, axis=-1)
    q = q.reshape(B, T, RET_HEADS, RET_DK) * (RET_DK ** -0.5)
    k = k.reshape(B, T, RET_HEADS, RET_DK)
    v = v.reshape(B, T, RET_HEADS, RET_DV)
    if use_rope:
        cos, sin = _rope_2d(T)
        q = _apply_rope(q, cos, sin)
        k = _apply_rope(k, cos, sin)
    lg = jax.nn.log_sigmoid(decay_logit.astype(jnp.float32))
    o_f, S_f = _retention_scan(q, k, v, lg[0], S0[:, 0])
    o_b, S_b = _retention_scan(q[:, ::-1], k[:, ::-1], v[:, ::-1], lg[1], S0[:, 1])
    o = o_f + o_b[:, ::-1]
    o = _rmsnorm(o, jnp.ones((RET_DV,), jnp.float32)).reshape(B, T, RET_WIDTH) * ret_g
    ya = jax.nn.silu(g) * o
    yb = bg * _short_conv(cg * xc, conv_w, conv_b)
    out = jnp.concatenate([ya, yb], axis=-1) @ w_out
    S_fin = jnp.stack([S_f, S_b], axis=1)
    return out, S_fin


def _mixer_c(h, w_in, v_g, w_s, b_s, w_out):
    B, T, _ = h.shape
    z = jax.nn.gelu(h @ w_in)
    u, v = jnp.split(z, 2, axis=-1)
    v = _rmsnorm(v, v_g)
    n = T // CMLP_CHUNK
    v = v.reshape(B, n, CMLP_CHUNK, CMLP_GROUPS, CMLP_WIDTH // CMLP_GROUPS)
    s = jnp.einsum('gpq,bnqgc->bnpgc', w_s, v) + b_s.T[None, None, :, :, None]
    return (u * s.reshape(B, T, CMLP_WIDTH)) @ w_out


def _swiglu(h, w_gate, w_up, w_down):
    return (jax.nn.silu(h @ w_gate) * (h @ w_up)) @ w_down


def _trunk(x, cvec, ret_init, use_rope, ada_w, ada_b, norm_mix_g, norm_ffn_g, w_in_ab, ret_decay_logit,
           ret_norm_g, conv_w, conv_b, w_out_ab, w_in_c, c_norm_g, w_spatial, b_spatial, w_out_c,
           w_gate, w_up, w_down, final_norm_g):
    states = []
    sc = jax.nn.silu(cvec)
    for l in range(DEPTH):
        mod = sc @ ada_w[l] + ada_b[l]
        sh1, sc1, g1, sh2, sc2, g2 = [m[:, None, :] for m in jnp.split(mod, 6, axis=-1)]
        h = _rmsnorm(x, norm_mix_g[l]) * (1.0 + sc1) + sh1
        if l % 2 == 0:
            i = l // 2
            out, S_fin = _mixer_ab(h, w_in_ab[i], ret_decay_logit[i], ret_norm_g[i], conv_w[i], conv_b[i],
                                   w_out_ab[i], ret_init[:, i], use_rope)
            states.append(S_fin)
        else:
            i = l // 2
            out = _mixer_c(h, w_in_c[i], c_norm_g[i], w_spatial[i], b_spatial[i], w_out_c[i])
        x = x + g1 * out
        h = _rmsnorm(x, norm_ffn_g[l]) * (1.0 + sc2) + sh2
        x = x + g2 * _swiglu(h, w_gate[l], w_up[l], w_down[l])
    return _rmsnorm(x, final_norm_g), jnp.stack(states, axis=1)


def setup_inputs(seed: int = 0) -> dict:
    key = jax.random.key(seed)
    ks = jax.random.split(key, 24)
    f32 = jnp.float32
    nrm = lambda k, shape, s: jax.random.normal(k, shape, f32) * s
    gamma = 1.0 - 2.0 ** (-5.0 - np.arange(RET_HEADS))
    base_logit = jnp.asarray(np.log(gamma / (1.0 - gamma)), f32)
    return {
        'x_prompt': nrm(ks[0], (BATCH, SEQ, D_MODEL), 1.0),
        'x_sample': nrm(ks[1], (DEC_BATCH, DEC_SEQ, D_MODEL), 1.0),
        'state_ret': nrm(ks[2], (DEC_BATCH, N_EVEN, 2, RET_HEADS, RET_DK, RET_DV), 0.5),
        'c': nrm(ks[3], (DEC_BATCH, D_MODEL), 1.0),
        'c_ctx': nrm(ks[4], (D_MODEL,), 1.0),
        'ada_w': nrm(ks[5], (DEPTH, D_MODEL, 6 * D_MODEL), 0.5 * D_MODEL ** -0.5),
        'ada_b': nrm(ks[6], (DEPTH, 6 * D_MODEL), 0.02),
        'norm_mix_g': 1.0 + nrm(ks[7], (DEPTH, D_MODEL), 0.02),
        'norm_ffn_g': 1.0 + nrm(ks[8], (DEPTH, D_MODEL), 0.02),
        'w_in_ab': nrm(ks[9], (N_EVEN, D_MODEL, AB_IN), D_MODEL ** -0.5),
        'ret_decay_logit': base_logit + nrm(ks[10], (N_EVEN, 2, RET_HEADS), 0.1),
        'ret_norm_g': 1.0 + nrm(ks[11], (N_EVEN, RET_WIDTH), 0.02),
        'conv_w': nrm(ks[12], (N_EVEN, CONV_K, CONV_WIDTH), CONV_K ** -0.5),
        'conv_b': nrm(ks[13], (N_EVEN, CONV_WIDTH), 0.02),
        'w_out_ab': nrm(ks[14], (N_EVEN, AB_OUT, D_MODEL), AB_OUT ** -0.5),
        'w_in_c': nrm(ks[15], (N_ODD, D_MODEL, 2 * CMLP_WIDTH), D_MODEL ** -0.5),
        'c_norm_g': 1.0 + nrm(ks[16], (N_ODD, CMLP_WIDTH), 0.02),
        'w_spatial': nrm(ks[17], (N_ODD, CMLP_GROUPS, CMLP_CHUNK, CMLP_CHUNK), CMLP_CHUNK ** -0.5),
        'b_spatial': 1.0 + nrm(ks[18], (N_ODD, CMLP_GROUPS, CMLP_CHUNK), 0.02),
        'w_out_c': nrm(ks[19], (N_ODD, CMLP_WIDTH, D_MODEL), CMLP_WIDTH ** -0.5),
        'w_gate': nrm(ks[20], (DEPTH, D_MODEL, FFN_HIDDEN), D_MODEL ** -0.5),
        'w_up': nrm(ks[21], (DEPTH, D_MODEL, FFN_HIDDEN), D_MODEL ** -0.5),
        'w_down': nrm(ks[22], (DEPTH, FFN_HIDDEN, D_MODEL), FFN_HIDDEN ** -0.5),
        'final_norm_g': 1.0 + nrm(ks[23], (D_MODEL,), 0.02),
    }


def reference(x_prompt, x_sample, state_ret, c, c_ctx, ada_w, ada_b, norm_mix_g, norm_ffn_g, w_in_ab,
              ret_decay_logit, ret_norm_g, conv_w, conv_b, w_out_ab, w_in_c, c_norm_g, w_spatial,
              b_spatial, w_out_c, w_gate, w_up, w_down, final_norm_g):
    weights = (ada_w, ada_b, norm_mix_g, norm_ffn_g, w_in_ab, ret_decay_logit, ret_norm_g, conv_w, conv_b,
               w_out_ab, w_in_c, c_norm_g, w_spatial, b_spatial, w_out_c, w_gate, w_up, w_down, final_norm_g)
    ctx_init = jnp.zeros((x_prompt.shape[0], N_EVEN, 2, RET_HEADS, RET_DK, RET_DV), x_prompt.dtype)
    y_prompt, new_state_ret = _trunk(x_prompt, c_ctx[None, :], ctx_init, False, *weights)
    y_sample, _ = _trunk(x_sample, c, state_ret, True, *weights)
    return (y_prompt, y_sample, new_state_ret)
```

```cpp
#include <hip/hip_runtime.h>
#include <hip/hip_cooperative_groups.h>
#include <cstdio>
#include <cstdint>
namespace cg = cooperative_groups;
namespace pg8 {
#define PG8_LAS __attribute__((address_space(3)))
typedef unsigned short bf16_t;
typedef short bf16x8 __attribute__((ext_vector_type(8)));
typedef float f32x4 __attribute__((ext_vector_type(4)));
typedef unsigned u32x4 __attribute__((ext_vector_type(4)));
typedef unsigned u32x2 __attribute__((ext_vector_type(2)));
constexpr int BM = 256, BK = 64, HALF = 128, HTB = HALF * BK * 2  , STAGE_BYTES = 8 * HTB, NXCD = 8, WGM = 8;

__host__ __device__ __forceinline__ int lds_byte(int r, int c) { const int st = (r >> 4) * 2 + (c >> 5), rr = r & 15, cc = c & 31, ob = rr * 64 + cc * 2; return st * 1024 + (ob ^ (((ob >> 9) & 1) << 5)); }
__host__ __device__ __forceinline__ void stage_rc(int b, int& R, int& C) { const int st = b / 1024, sb = b % 1024, swz = sb ^ (((sb >> 9) & 1) << 5); R = (st >> 1) * 16 + swz / 64; C = (st & 1) * 32 + (swz % 64) / 2; }
__host__ __device__ __forceinline__ int perm32(int rho) { const int n = rho >> 4, i = rho & 15; return 8 * (i >> 2) + 4 * n + (i & 3); }

struct Unit { int pm, pn; };
struct Gemm { const bf16_t* A; const bf16_t* Bt; int M, N, K; };

struct StaticOrder {
    int nM, nN, nwg, G, c;
    __host__ __device__ void init(int M, int N, int G_, int c_) { nM = M / BM; nN = N / BM; nwg = nM * nN; G = G_; c = c_; }
    __host__ __device__ bool next(int i, Unit& u) const {
        const long L = (long)i * G + c; if (L >= nwg) return false;
        int wgid = (int)L; { const int q = nwg / NXCD, r = nwg % NXCD, xcd = wgid % NXCD, off = wgid / NXCD; wgid = (xcd < r ? xcd * (q + 1) : r * (q + 1) + (xcd - r) * q) + off; }
        const int nig = WGM * nN, gid = wgid / nig, fm = gid * WGM, gsz = (nM - fm) < WGM ? (nM - fm) : WGM;
        u.pm = fm + ((wgid % nig) % gsz); u.pn = (wgid % nig) / gsz; return true;
    }
    __device__ __forceinline__ void a_ready(const Unit&) const {}
    __device__ __forceinline__ void done(const Unit&) const {}
};

typedef float f32x2_cv __attribute__((ext_vector_type(2))); typedef __bf16 bf16x2_cv __attribute__((ext_vector_type(2)));
__device__ __forceinline__ unsigned cvt_pk_bf16(float lo, float hi) { const f32x2_cv v = {lo, hi}; const bf16x2_cv b = __builtin_convertvector(v, bf16x2_cv); return __builtin_bit_cast(unsigned, b); }
typedef float f32x2 __attribute__((ext_vector_type(2)));
__device__ __forceinline__ float fast_sigmoid(float x) { return __builtin_amdgcn_rcpf(1.0f + __builtin_amdgcn_exp2f(-1.4426950408889634f * x)); }
struct EpiStoreBf16 {
    static constexpr bool PERM = true, AFTER_DRAIN = false;
    bf16_t* O; int ldc;
    __device__ __forceinline__ void operator()(const f32x4 (&acc)[2][2][4][2], const Unit& u, int wr, int wc, int fr, int fq) const {
        const int row0 = u.pm * BM + wr * 64 + fr, col0 = u.pn * BM + wc * 32 + 8 * fq;
#pragma unroll
        for (int ai = 0; ai < 2; ++ai)
#pragma unroll
            for (int m = 0; m < 4; ++m) { bf16_t* rowp = O + (size_t)(row0 + ai * HALF + m * 16) * ldc + col0;
#pragma unroll
                for (int bj = 0; bj < 2; ++bj) { const f32x4 v0 = acc[ai][bj][m][0], v1 = acc[ai][bj][m][1];
                    u32x4 w; w.x = cvt_pk_bf16(v0[0], v0[1]); w.y = cvt_pk_bf16(v0[2], v0[3]); w.z = cvt_pk_bf16(v1[0], v1[1]); w.w = cvt_pk_bf16(v1[2], v1[3]);
                    *(u32x4*)(rowp + bj * HALF) = w; } }
    }
};
__device__ __forceinline__ void load_rstd(const float* rsq, int row0, int fq, float (&rstd)[2][4]) {
#pragma unroll
    for (int ai = 0; ai < 2; ++ai)
#pragma unroll
        for (int m = 0; m < 4; ++m) { const f32x4 p = *(const f32x4*)(rsq + (size_t)(row0 + ai * HALF + m * 16) * 16 + 4 * fq); float s = (p[0] + p[1]) + (p[2] + p[3]);
            s += __shfl_xor(s, 16); s += __shfl_xor(s, 32); rstd[ai][m] = rsqrtf(s * (1.0f / 1024.0f) + 1e-6f); }
}
struct EpiGeluSq {
    static constexpr bool PERM = true, AFTER_DRAIN = false;
    bf16_t* O; int ldc; float* vsq; int pn_v; const float* rsq; const float* bias; int nbias;
    __device__ __forceinline__ void operator()(const f32x4 (&acc)[2][2][4][2], const Unit& u, int wr, int wc, int fr, int fq) const {
        const int row0 = u.pm * BM + wr * 64 + fr, col0 = u.pn * BM + wc * 32 + 8 * fq;
        const int cb = u.pm < 32 ? 0 : 1 + ((u.pm - 32) >> 4);
        float rstd[2][4]; load_rstd(rsq, row0, fq, rstd);
        f32x4 bv[2][2];
#pragma unroll
        for (int bj = 0; bj < 2; ++bj)
#pragma unroll
            for (int n = 0; n < 2; ++n) bv[bj][n] = *(const f32x4*)(bias + (size_t)cb * nbias + col0 + bj * HALF + 4 * n);
#pragma unroll
        for (int ai = 0; ai < 2; ++ai)
#pragma unroll
            for (int m = 0; m < 4; ++m) { const int row = row0 + ai * HALF + m * 16; bf16_t* rowp = O + (size_t)row * ldc + col0; float ss = 0.f;
#pragma unroll
                for (int bj = 0; bj < 2; ++bj) { f32x4 v[2];
#pragma unroll
                    for (int n = 0; n < 2; ++n)
#pragma unroll
                        for (int j = 0; j < 4; ++j) { const float x = acc[ai][bj][m][n][j] * rstd[ai][m] + bv[bj][n][j]; const float y = 0.7978845608028654f * (x + 0.044715f * x * x * x); const float gl = x * fast_sigmoid(2.0f * y); v[n][j] = gl; ss += gl * gl; }
                    u32x4 w; w.x = cvt_pk_bf16(v[0][0], v[0][1]); w.y = cvt_pk_bf16(v[0][2], v[0][3]); w.z = cvt_pk_bf16(v[1][0], v[1][1]); w.w = cvt_pk_bf16(v[1][2], v[1][3]);
                    *(u32x4*)(rowp + bj * HALF) = w; }
                ss += __shfl_xor(ss, 16); ss += __shfl_xor(ss, 32);
                if (u.pn >= pn_v && fq == 0) vsq[(size_t)row * 16 + (u.pn - pn_v) * 4 + wc] = ss; }
    }
};
struct EpiSwiglu {
    static constexpr bool PERM = true, AFTER_DRAIN = false;
    bf16_t* O; int ldc; const float* rsq; const float* bias; int nbias;
    __device__ __forceinline__ void operator()(const f32x4 (&acc)[2][2][4][2], const Unit& u, int wr, int wc, int fr, int fq) const {
        const int row0 = u.pm * BM + wr * 64 + fr, col0 = u.pn * HALF + wc * 32 + 8 * fq;
        const int cb = u.pm < 32 ? 0 : 1 + ((u.pm - 32) >> 4);
        float rstd[2][4]; load_rstd(rsq, row0, fq, rstd);
        f32x4 bv[2][2];
#pragma unroll
        for (int bj = 0; bj < 2; ++bj)
#pragma unroll
            for (int n = 0; n < 2; ++n) bv[bj][n] = *(const f32x4*)(bias + (size_t)cb * nbias + u.pn * BM + bj * HALF + wc * 32 + 8 * fq + 4 * n);
#pragma unroll
        for (int ai = 0; ai < 2; ++ai)
#pragma unroll
            for (int m = 0; m < 4; ++m) { bf16_t* rowp = O + (size_t)(row0 + ai * HALF + m * 16) * ldc + col0; f32x4 v[2];
#pragma unroll
                for (int n = 0; n < 2; ++n)
#pragma unroll
                    for (int j = 0; j < 4; ++j) { const float g = acc[ai][0][m][n][j] * rstd[ai][m] + bv[0][n][j], up = acc[ai][1][m][n][j] * rstd[ai][m] + bv[1][n][j]; v[n][j] = g * fast_sigmoid(g) * up; }
                u32x4 w; w.x = cvt_pk_bf16(v[0][0], v[0][1]); w.y = cvt_pk_bf16(v[0][2], v[0][3]); w.z = cvt_pk_bf16(v[1][0], v[1][1]); w.w = cvt_pk_bf16(v[1][2], v[1][3]);
                *(u32x4*)rowp = w; }
    }
};
struct EpiResid {
    static constexpr bool PERM = false, AFTER_DRAIN = false;
    const float* b0; const float* b1; float* out; const float* gate;
    __device__ __forceinline__ void operator()(const f32x4 (&acc)[2][2][4][2], const Unit& u, int wr, int wc, int fr, int fq) const {
        const int cb = u.pm < 32 ? 0 : 1 + ((u.pm - 32) >> 4);
        const float* base = u.pm < 32 ? b0 + (size_t)u.pm * BM * 1024 : b1 + (size_t)(u.pm - 32) * BM * 1024;
        const int r0 = wr * 64 + fr, col0 = u.pn * BM + wc * 32 + 4 * fq;
        f32x4 gv[2][2];
#pragma unroll
        for (int bj = 0; bj < 2; ++bj)
#pragma unroll
            for (int n = 0; n < 2; ++n) gv[bj][n] = *(const f32x4*)(gate + cb * 6144 + col0 + bj * HALF + n * 16);
#pragma unroll
        for (int ai = 0; ai < 2; ++ai)
#pragma unroll
            for (int m = 0; m < 4; ++m) { const int lrow = r0 + ai * HALF + m * 16; const float* bp = base + (size_t)lrow * 1024 + col0; float* op = out + (size_t)(u.pm * BM + lrow) * 1024 + col0;
#pragma unroll
                for (int bj = 0; bj < 2; ++bj)
#pragma unroll
                    for (int n = 0; n < 2; ++n) { const f32x4 bs = *(const f32x4*)(bp + bj * HALF + n * 16); *(f32x4*)(op + bj * HALF + n * 16) = bs + gv[bj][n] * acc[ai][bj][m][n]; } }
    }
};
struct EpiResidNorm {
    static constexpr bool PERM = false, AFTER_DRAIN = false;
    const float* b0; const float* b1; float* out; const float* gate; bf16_t* A; const float* gn; const float* sc; float* rsq;
    __device__ __forceinline__ void operator()(const f32x4 (&acc)[2][2][4][2], const Unit& u, int wr, int wc, int fr, int fq) const {
        const int cb = u.pm < 32 ? 0 : 1 + ((u.pm - 32) >> 4);
        const float* base = u.pm < 32 ? b0 + (size_t)u.pm * BM * 1024 : b1 + (size_t)(u.pm - 32) * BM * 1024;
        const int r0 = wr * 64 + fr, col0 = u.pn * BM + wc * 32 + 4 * fq;
        f32x4 gv[2][2], gm[2][2];
#pragma unroll
        for (int bj = 0; bj < 2; ++bj)
#pragma unroll
            for (int n = 0; n < 2; ++n) { const int c = col0 + bj * HALF + n * 16; gv[bj][n] = *(const f32x4*)(gate + cb * 6144 + c);
                gm[bj][n] = *(const f32x4*)(gn + c) * (*(const f32x4*)(sc + cb * 6144 + c) + 1.0f); }
#pragma unroll
        for (int ai = 0; ai < 2; ++ai)
#pragma unroll
            for (int m = 0; m < 4; ++m) { const int lrow = r0 + ai * HALF + m * 16; const size_t grow = (size_t)(u.pm * BM + lrow);
                const float* bp = base + (size_t)lrow * 1024 + col0; float* op = out + grow * 1024 + col0; bf16_t* ap = A + grow * 1024 + col0; float ss = 0.f;
#pragma unroll
                for (int bj = 0; bj < 2; ++bj)
#pragma unroll
                    for (int n = 0; n < 2; ++n) { const f32x4 bs = *(const f32x4*)(bp + bj * HALF + n * 16); const f32x4 xn = bs + gv[bj][n] * acc[ai][bj][m][n];
                        *(f32x4*)(op + bj * HALF + n * 16) = xn; ss += (xn[0] * xn[0] + xn[1] * xn[1]) + (xn[2] * xn[2] + xn[3] * xn[3]);
                        const f32x4 an = xn * gm[bj][n]; u32x2 w; w.x = cvt_pk_bf16(an[0], an[1]); w.y = cvt_pk_bf16(an[2], an[3]);
                        *(u32x2*)(ap + bj * HALF + n * 16) = w; }
                ss += __shfl_xor(ss, 16); ss += __shfl_xor(ss, 32);
                if (fq == 0) rsq[grow * 16 + u.pn * 4 + wc] = ss; }
    }
};
template <class Epi, class Sched, bool ALIGN_EPI = false, bool SP2 = false>
__device__ __forceinline__ void gemm_phase(PG8_LAS unsigned char* lds, const Gemm g, const Sched& S, const Epi& E) {
    const int tid = threadIdx.x, wid = __builtin_amdgcn_readfirstlane(tid >> 6), lane = tid & 63, wr = wid >> 2, wc = wid & 3, fr = lane & 15, fq = lane >> 4;
    const int K = g.K, nt = K / BK;
    unsigned voffA[2], voffB[2];
#pragma unroll
    for (int i = 0; i < 2; ++i) { int R, C; stage_rc(tid * 16 + i * 8192, R, C); const int Rb = Epi::PERM ? ((R & ~31) + perm32(R & 31)) : R;
        voffA[i] = (unsigned)(R * K + C) * 2u; voffB[i] = (unsigned)(Rb * K + C) * 2u; }
    const size_t kstep = (size_t)(BK * 2);
    const size_t hstep = (size_t)HALF * K * 2;
    const size_t tstep = 2 * hstep;
    const unsigned ldsw = (unsigned)wid * 1024u;
    const int aoff = lds_byte(wr * 64 + fr, fq * 8), boff = lds_byte(wc * 32 + fr, fq * 8);
#define PG8_SA(b, h) (((b) * 2 + (h)) * HTB)
#define PG8_SB(b, h) ((4 + (b) * 2 + (h)) * HTB)
#define PG8_STAGE(bufoff, gbase, voff) do { _Pragma("unroll") for (int _i = 0; _i < 2; ++_i) \
        __builtin_amdgcn_global_load_lds((const unsigned*)((const char*)(gbase) + (voff)[_i]), (PG8_LAS unsigned*)(lds + (bufoff) + ldsw + _i * 8192), 16, 0, 0); } while (0)
#define PG8_LDA(dst, b, h) do { _Pragma("unroll") for (int m = 0; m < 4; ++m) _Pragma("unroll") for (int k = 0; k < 2; ++k) dst[m][k] = *(const PG8_LAS bf16x8*)(lds + PG8_SA(b, h) + aoff + m * 2048 + k * 1024); } while (0)
#define PG8_LDB(dst, b, h) do { _Pragma("unroll") for (int n = 0; n < 2; ++n) _Pragma("unroll") for (int k = 0; k < 2; ++k) dst[n][k] = *(const PG8_LAS bf16x8*)(lds + PG8_SB(b, h) + boff + n * 2048 + k * 1024); } while (0)
#define PG8_MMA(ai, bj, At, Bt) do { __builtin_amdgcn_s_setprio(1); _Pragma("unroll") for (int m = 0; m < 4; ++m) _Pragma("unroll") for (int n = 0; n < 2; ++n) _Pragma("unroll") for (int k = 0; k < 2; ++k) \
        acc[ai][bj][m][n] = __builtin_amdgcn_mfma_f32_16x16x32_bf16(Bt[n][k], At[m][k], acc[ai][bj][m][n], 0, 0, 0); __builtin_amdgcn_s_setprio(0); } while (0)
#define PG8_WAIT_V(n) asm volatile("s_waitcnt vmcnt(" #n ")" ::: "memory")
#define PG8_WAIT_L(n) asm volatile("s_waitcnt lgkmcnt(" #n ")" ::: "memory")
#define PG8_BAR __builtin_amdgcn_s_barrier()
#define PG8_SCHED __builtin_amdgcn_sched_barrier(0)
    Unit cur, nxt; int ui = 0;
    if (!S.next(0, cur)) return;
    f32x4 acc[2][2][4][2];
#pragma unroll
    for (int a = 0; a < 2; ++a)
#pragma unroll
        for (int b = 0; b < 2; ++b)
#pragma unroll
            for (int m = 0; m < 4; ++m)
#pragma unroll
                for (int n = 0; n < 2; ++n) acc[a][b][m][n] = (f32x4){0.f, 0.f, 0.f, 0.f};
    bf16x8 At[4][2], B0[2][2], B1[2][2];
    const char* cA = (const char*)g.A + (size_t)cur.pm * tstep; const char* cB = (const char*)g.Bt + (size_t)cur.pn * tstep;
    S.a_ready(cur);
    if constexpr (SP2) {
        PG8_STAGE(PG8_SB(0, 0), cB, voffB); PG8_STAGE(PG8_SB(0, 1), cB + hstep, voffB); PG8_STAGE(PG8_SA(0, 0), cA, voffA); PG8_STAGE(PG8_SA(0, 1), cA + hstep, voffA);
        if (wr == 1) PG8_BAR;
        PG8_WAIT_V(2); PG8_BAR;
        PG8_STAGE(PG8_SB(1, 0), cB + kstep, voffB); PG8_STAGE(PG8_SA(1, 0), cA + kstep, voffA); PG8_STAGE(PG8_SB(1, 1), cB + hstep + kstep, voffB);
        PG8_WAIT_V(6); PG8_BAR;
    } else {
        PG8_STAGE(PG8_SB(0, 0), cB, voffB); PG8_STAGE(PG8_SA(0, 0), cA, voffA); PG8_STAGE(PG8_SB(0, 1), cB + hstep, voffB); PG8_STAGE(PG8_SA(0, 1), cA + hstep, voffA);
        if (wr == 1) PG8_BAR;
        PG8_WAIT_V(4); PG8_BAR;
        PG8_STAGE(PG8_SB(1, 0), cB + kstep, voffB); PG8_STAGE(PG8_SA(1, 0), cA + kstep, voffA); PG8_STAGE(PG8_SB(1, 1), cB + hstep + kstep, voffB);
        PG8_WAIT_V(6); PG8_BAR;
    }
    for (;;) {
        const bool has_next = S.next(ui + 1, nxt);
        const char* nA = has_next ? (const char*)g.A + (size_t)nxt.pm * tstep : cA; const char* nB = has_next ? (const char*)g.Bt + (size_t)nxt.pn * tstep : cB;
        for (int t = 0; t < nt; t += 2) {
            const bool last = (t == nt - 2);
            const char* a1 = cA + (size_t)(t + 1) * kstep;
            const char* a2 = last ? nA : cA + (size_t)(t + 2) * kstep; const char* b2 = last ? nB : cB + (size_t)(t + 2) * kstep;
            const char* a3 = a2 + kstep; const char* b3 = b2 + kstep;
            if (last && has_next) S.a_ready(nxt);
            if constexpr (SP2) {
            PG8_LDB(B0, 0, 0); PG8_LDB(B1, 0, 1); PG8_SCHED; PG8_LDA(At, 0, 0); PG8_STAGE(PG8_SA(1, 1), a1 + hstep, voffA);
            PG8_WAIT_V(8); PG8_WAIT_L(0); PG8_BAR; PG8_MMA(0, 0, At, B0); PG8_MMA(0, 1, At, B1); PG8_BAR; PG8_SCHED;
            PG8_LDA(At, 0, 1); PG8_STAGE(PG8_SB(0, 0), b2, voffB); PG8_STAGE(PG8_SB(0, 1), b2 + hstep, voffB); PG8_STAGE(PG8_SA(0, 0), a2, voffA);
            PG8_WAIT_V(8); PG8_WAIT_L(0); PG8_BAR; PG8_MMA(1, 0, At, B0); PG8_MMA(1, 1, At, B1); PG8_BAR; PG8_SCHED;
            PG8_LDB(B0, 1, 0); PG8_LDB(B1, 1, 1); PG8_SCHED; PG8_LDA(At, 1, 0); PG8_STAGE(PG8_SA(0, 1), a2 + hstep, voffA);
            PG8_WAIT_V(8); PG8_WAIT_L(0); PG8_BAR; PG8_MMA(0, 0, At, B0); PG8_MMA(0, 1, At, B1); PG8_BAR; PG8_SCHED;
            PG8_LDA(At, 1, 1); PG8_STAGE(PG8_SB(1, 0), b3, voffB); PG8_STAGE(PG8_SB(1, 1), b3 + hstep, voffB); PG8_STAGE(PG8_SA(1, 0), a3, voffA);
            PG8_WAIT_V(8); PG8_WAIT_L(0); PG8_BAR; PG8_MMA(1, 0, At, B0); PG8_MMA(1, 1, At, B1); PG8_BAR; PG8_SCHED;
            } else {
            PG8_LDB(B0, 0, 0); PG8_SCHED; PG8_LDA(At, 0, 0); PG8_STAGE(PG8_SA(1, 1), a1 + hstep, voffA);
            PG8_WAIT_L(8); PG8_BAR; PG8_WAIT_L(0); PG8_MMA(0, 0, At, B0); PG8_BAR; PG8_SCHED;
            PG8_LDB(B1, 0, 1); PG8_STAGE(PG8_SB(0, 0), b2, voffB);
            PG8_BAR; PG8_WAIT_L(0); PG8_MMA(0, 1, At, B1); PG8_BAR;
            PG8_LDA(At, 0, 1); PG8_STAGE(PG8_SA(0, 0), a2, voffA);
            PG8_BAR; PG8_WAIT_L(0); PG8_MMA(1, 0, At, B0); PG8_BAR; PG8_SCHED;
            PG8_STAGE(PG8_SB(0, 1), b2 + hstep, voffB);
            PG8_WAIT_V(6); PG8_BAR; PG8_MMA(1, 1, At, B1); PG8_BAR;
            PG8_LDB(B0, 1, 0); PG8_SCHED; PG8_LDA(At, 1, 0); PG8_STAGE(PG8_SA(0, 1), a2 + hstep, voffA);
            PG8_WAIT_L(8); PG8_BAR; PG8_WAIT_L(0); PG8_MMA(0, 0, At, B0); PG8_BAR; PG8_SCHED;
            PG8_LDB(B1, 1, 1); PG8_STAGE(PG8_SB(1, 0), b3, voffB);
            PG8_BAR; PG8_WAIT_L(0); PG8_MMA(0, 1, At, B1); PG8_BAR;
            PG8_LDA(At, 1, 1); PG8_STAGE(PG8_SA(1, 0), a3, voffA);
            PG8_BAR; PG8_WAIT_L(0); PG8_MMA(1, 0, At, B0); PG8_BAR; PG8_SCHED;
            PG8_STAGE(PG8_SB(1, 1), b3 + hstep, voffB);
            PG8_WAIT_V(6); PG8_BAR; PG8_MMA(1, 1, At, B1); PG8_BAR;
            }
        }
        if constexpr (ALIGN_EPI) { if (wr == 0) PG8_BAR; }
        if constexpr (!Epi::AFTER_DRAIN) { E(acc, cur, wr, wc, fr, fq); S.done(cur); }
        if (!has_next) break;
#pragma unroll
        for (int a = 0; a < 2; ++a)
#pragma unroll
            for (int b = 0; b < 2; ++b)
#pragma unroll
                for (int m = 0; m < 4; ++m)
#pragma unroll
                    for (int n = 0; n < 2; ++n) acc[a][b][m][n] = (f32x4){0.f, 0.f, 0.f, 0.f};
        cur = nxt; cA = nA; cB = nB; ++ui;
        if constexpr (ALIGN_EPI) { if (wr == 1) PG8_BAR; }
    }
    PG8_WAIT_V(0);
    if constexpr (!ALIGN_EPI) { if (wr == 0) PG8_BAR; }
    PG8_BAR;
    if constexpr (Epi::AFTER_DRAIN) { E.fused(acc, cur, wr, wc, fr, fq, lds, wid, lane); S.done(cur); }
#undef PG8_SA
#undef PG8_SB
#undef PG8_STAGE
#undef PG8_LDA
#undef PG8_LDB
#undef PG8_MMA
#undef PG8_WAIT_V
#undef PG8_WAIT_L
#undef PG8_BAR
#undef PG8_SCHED
}
}
constexpr int D = 1024, MCTX = 8192, MLAT = 32768, M = MCTX + MLAT;
constexpr int NAB = 3584, FF = 2816, NGU = 2 * FF, NC = 2048, NCOND = 9, MODW = 6 * D;
constexpr float EPS = 1e-6f;
constexpr int NWAVES = 8, NTHREADS = 512;
constexpr int N_PHASES = 18;
#ifndef PH_MASK
#define PH_MASK 0x3ffff
#endif
#ifndef ONE_LAUNCH
#define ONE_LAUNCH 1
#endif
constexpr size_t MiB = 1u << 20;
constexpr size_t WS_MOD = 0;
constexpr size_t WS_ROPE = 1 * MiB;
constexpr size_t WS_VSQ = 2 * MiB;
constexpr size_t WS_SHW = 512 * 1024;
constexpr size_t WS_RSQ = 4 * MiB + 512 * 1024;
constexpr size_t WS_BAR = 7 * MiB + 512 * 1024;
constexpr size_t WS_WAB = 8 * MiB;
constexpr size_t WS_WOAB = 15 * MiB;
constexpr size_t WS_WINC = 17 * MiB;
constexpr size_t WS_WOC = 21 * MiB;
constexpr size_t WS_WGU = 23 * MiB;
constexpr size_t WS_WDN = 45 * MiB;
constexpr size_t WS_HB = 56 * MiB;
constexpr size_t WS_YB = 136 * MiB;
constexpr size_t WS_P = 216 * MiB;
constexpr size_t WS_END = 496 * MiB;
constexpr int LDS_BYTES = 147456;
constexpr int MISC_OFF = LDS_BYTES - 64;
constexpr int TS = 136, TILE_B = 128 * TS * 2;
constexpr int VS = 264;

#define LAS __attribute__((address_space(3)))
typedef unsigned short bf16;
typedef unsigned v4u __attribute__((ext_vector_type(4)));
typedef unsigned v2u __attribute__((ext_vector_type(2)));
typedef float f32x4 __attribute__((ext_vector_type(4)));
typedef short bf16x8 __attribute__((ext_vector_type(8)));
typedef short s16x4 __attribute__((ext_vector_type(4)));
typedef LAS unsigned char* ldsp;

__device__ __forceinline__ float bflo(unsigned w) { return __uint_as_float(w << 16); }
__device__ __forceinline__ float bfhi(unsigned w) { return __uint_as_float(w & 0xffff0000u); }
__device__ __forceinline__ unsigned pk2(float lo, float hi) { return pg8::cvt_pk_bf16(lo, hi); }
__device__ __forceinline__ s16x4 vtr(const LAS unsigned char* p) { return __builtin_bit_cast(s16x4, __builtin_amdgcn_ds_read_tr16_b64_v4i16((LAS s16x4*)p)); }
__device__ __forceinline__ bf16x8 tr_frag(const LAS unsigned char* p, int off2) { const s16x4 a = vtr(p), b = vtr(p + off2); return __builtin_shufflevector(a, b, 0, 1, 2, 3, 4, 5, 6, 7); }
__device__ __forceinline__ f32x4 mfma16(bf16x8 a, bf16x8 b, f32x4 c) { return __builtin_amdgcn_mfma_f32_16x16x32_bf16(a, b, c, 0, 0, 0); }
__device__ __forceinline__ float wave_sum(float v) {
#pragma unroll
    for (int o = 1; o < 64; o <<= 1) v += __shfl_xor(v, o);
    return v;
}
__device__ __forceinline__ float log2_sigmoid(float x) { return -log1pf(expf(-x)) * 1.4426950408889634f; }

struct Args {
    const float* in[24]; float* out; unsigned char* ws; int ph_lo, ph_hi;
};

__device__ __forceinline__ void transpose_item(const float* W, int K, int N, bf16* WT, int k0, int n0, int dst_row0, float scale, LAS float* scr, int lane) {
#pragma unroll 8
    for (int i = 0; i < 32; ++i) { const int kk = 2 * i + (lane >> 5); scr[kk * 33 + (lane & 31)] = W[(size_t)(k0 + kk) * N + n0 + (lane & 31)]; }
    asm volatile("s_waitcnt lgkmcnt(0)" ::: "memory");
    const int c = lane & 7;
#pragma unroll
    for (int j = 0; j < 4; ++j) { const int n = (lane >> 3) + 8 * j; const LAS float* s = scr + (8 * c) * 33 + n;
        v4u o; o.x = pk2(s[0 * 33] * scale, s[1 * 33] * scale); o.y = pk2(s[2 * 33] * scale, s[3 * 33] * scale); o.z = pk2(s[4 * 33] * scale, s[5 * 33] * scale); o.w = pk2(s[6 * 33] * scale, s[7 * 33] * scale);
        *(v4u*)(WT + (size_t)(dst_row0 + n) * K + k0 + 8 * c) = o; }
    asm volatile("s_waitcnt lgkmcnt(0)" ::: "memory");
}

__device__ __forceinline__ void p0_prologue(const Args& a, ldsp lds, int tid, int lane, int wave) {
    unsigned char* ws = a.ws;
    LAS float* L = (LAS float*)lds;
    const int bx = blockIdx.x, G = gridDim.x;
    for (int job = bx; job < 192; job += G) {
        const float* c = a.in[3]; const float* c_ctx = a.in[4]; const float* ada_w = a.in[5]; const float* ada_b = a.in[6];
        float* mod = (float*)(ws + WS_MOD);
        for (int e = tid; e < NCOND * 1024; e += NTHREADS) { const int b = e >> 10, k = e & 1023; const float cv = (b == 0) ? c_ctx[k] : c[(b - 1) * 1024 + k]; L[e] = cv / (1.0f + __expf(-cv)); }
        __syncthreads();
        const int l = job / 96, n0 = (job % 96) * 64;
        const float* W = ada_w + ((size_t)l * 1024 + 128 * wave) * MODW + n0 + lane;
        float acc[NCOND];
#pragma unroll
        for (int b = 0; b < NCOND; ++b) acc[b] = 0.f;
        for (int kk = 0; kk < 128; kk += 8) {
            float w[8];
#pragma unroll
            for (int u = 0; u < 8; ++u) w[u] = W[(size_t)(kk + u) * MODW];
#pragma unroll
            for (int u = 0; u < 8; ++u)
#pragma unroll
                for (int b = 0; b < NCOND; ++b) acc[b] += L[b * 1024 + 128 * wave + kk + u] * w[u];
        }
        LAS float* red = L + NCOND * 1024;
#pragma unroll
        for (int b = 0; b < NCOND; ++b) red[(wave * NCOND + b) * 64 + lane] = acc[b];
        __syncthreads();
        for (int e = tid; e < NCOND * 64; e += NTHREADS) { const int b = e >> 6, ln = e & 63; float s = ada_b[l * MODW + n0 + ln];
#pragma unroll
            for (int w = 0; w < 8; ++w) s += red[(w * NCOND + b) * 64 + ln];
            mod[(size_t)(l * NCOND + b) * MODW + n0 + ln] = s; }
        __syncthreads();
    }
    if (bx == G - 1) {
        float* tab = (float*)(ws + WS_ROPE);
        for (int e = tid; e < 2048; e += NTHREADS) { const int pos = e >> 5, f = e & 31; const float fr = exp2f(-(float)f * (13.287712379549449f / 32.0f)); const float ang = (float)pos * fr;
            float rev = ang * 0.15915494309189535f; rev -= floorf(rev); tab[e] = __builtin_amdgcn_cosf(rev); tab[2048 + e] = __builtin_amdgcn_sinf(rev); }
    }
    {
        LAS float* scr = L + wave * (64 * 33);
        const int gw = bx * NWAVES + wave, NGW = G * NWAVES;
        for (int it = gw; it < 12288; it += NGW) {
            int r = it; const float* W; int K, N; bf16* WT; int mode = 0;
            if (r < 1792) { W = a.in[9]; K = 1024; N = NAB; WT = (bf16*)(ws + WS_WAB); mode = 3; }
            else if ((r -= 1792) < 512) { W = a.in[14]; K = 1024; N = 1024; WT = (bf16*)(ws + WS_WOAB); }
            else if ((r -= 512) < 1024) { W = a.in[15]; K = 1024; N = NC; WT = (bf16*)(ws + WS_WINC); }
            else if ((r -= 1024) < 512) { W = a.in[19]; K = 1024; N = 1024; WT = (bf16*)(ws + WS_WOC); }
            else if ((r -= 512) < 2816) { const int l = r / 1408; r -= l * 1408; W = a.in[20] + (size_t)l * 1024 * FF; K = 1024; N = FF; WT = (bf16*)(ws + WS_WGU) + (size_t)l * NGU * 1024; mode = 1; }
            else if ((r -= 2816) < 2816) { const int l = r / 1408; r -= l * 1408; W = a.in[21] + (size_t)l * 1024 * FF; K = 1024; N = FF; WT = (bf16*)(ws + WS_WGU) + (size_t)l * NGU * 1024; mode = 2; }
            else { r -= 2816; const int l = r / 1408; r -= l * 1408; W = a.in[22] + (size_t)l * FF * 1024; K = FF; N = 1024; WT = (bf16*)(ws + WS_WDN) + (size_t)l * 1024 * FF; }
            const int nblk = N / 32, kb = r / nblk, nb = r % nblk, k0 = 64 * kb, n0 = 32 * nb;
            int drow = n0; float scale = 1.0f;
            if (mode == 1) drow = (n0 >> 7) * 256 + (n0 & 127);
            else if (mode == 2) drow = (n0 >> 7) * 256 + 128 + (n0 & 127);
            else if (mode == 3 && n0 < 512) scale = 0.08838834764831845f;
            transpose_item(W, K, N, WT, k0, n0, drow, scale, scr, lane);
        }
    }
}

template <bool FIRST>
__device__ __forceinline__ void norm_pass(const Args& a, const float* gn, const float* modl, int off_sh, int off_sc, bf16* outp, int lane, int wave) {
    const int gw = blockIdx.x * NWAVES + wave, NGW = gridDim.x * NWAVES;
    for (int m = gw; m < M; m += NGW) {
        const float* xrow = FIRST ? (m < MCTX ? a.in[0] + (size_t)m * D : a.in[1] + (size_t)(m - MCTX) * D) : a.out + (size_t)m * D;
        const int cb = m < MCTX ? 0 : 1 + ((m - MCTX) >> 12);
        const f32x4* xr = (const f32x4*)xrow + lane;
        f32x4 v[4]; float s = 0.f;
#pragma unroll
        for (int j = 0; j < 4; ++j) { v[j] = xr[64 * j]; s += (v[j].x * v[j].x + v[j].y * v[j].y) + (v[j].z * v[j].z + v[j].w * v[j].w); }
        const float rstd = rsqrtf(wave_sum(s) * (1.0f / D) + EPS);
        const float* mrow = modl + (size_t)cb * MODW;
        v2u* o8 = (v2u*)(outp + (size_t)m * D) + lane;
#pragma unroll
        for (int j = 0; j < 4; ++j) { const int col = 4 * lane + 256 * j;
            const f32x4 g4 = *(const f32x4*)(gn + col), sc4 = *(const f32x4*)(mrow + off_sc + col), sh4 = *(const f32x4*)(mrow + off_sh + col);
            const f32x4 o = v[j] * rstd * g4 * (sc4 + 1.0f) + sh4;
            v2u w; w.x = pk2(o.x, o.y); w.y = pk2(o.z, o.w); o8[64 * j] = w; }
    }
}
__device__ __forceinline__ void final_norm(const Args& a, const float* gn, int lane, int wave) {
    const int gw = blockIdx.x * NWAVES + wave, NGW = gridDim.x * NWAVES;
    for (int m = gw; m < M; m += NGW) {
        f32x4* xr = (f32x4*)(a.out + (size_t)m * D) + lane;
        f32x4 v[4]; float s = 0.f;
#pragma unroll
        for (int j = 0; j < 4; ++j) { v[j] = xr[64 * j]; s += (v[j].x * v[j].x + v[j].y * v[j].y) + (v[j].z * v[j].z + v[j].w * v[j].w); }
        const float rstd = rsqrtf(wave_sum(s) * (1.0f / D) + EPS);
#pragma unroll
        for (int j = 0; j < 4; ++j) { const f32x4 g4 = *(const f32x4*)(gn + 4 * lane + 256 * j); xr[64 * j] = v[j] * rstd * g4; }
    }
}

__device__ __forceinline__ void load_rope_tile(ldsp T, const bf16* src, bool rope, int tpos0, const float* tab, int tid) {
#pragma unroll
    for (int rep = 0; rep < 2; ++rep) { const int it = tid + rep * NTHREADS, tok = it >> 3, d0 = (it & 7) * 8;
        v4u x1 = *(const v4u*)(src + (size_t)tok * NAB + d0), x2 = *(const v4u*)(src + (size_t)tok * NAB + 64 + d0);
        if (rope) { const int tpos = tpos0 + tok, pos = d0 < 32 ? (tpos >> 6) : (tpos & 63), f0 = d0 & 31;
            const f32x4 c0 = *(const f32x4*)(tab + pos * 32 + f0), c1 = *(const f32x4*)(tab + pos * 32 + f0 + 4), s0 = *(const f32x4*)(tab + 2048 + pos * 32 + f0), s1 = *(const f32x4*)(tab + 2048 + pos * 32 + f0 + 4);
            const float cs[8] = {c0.x, c0.y, c0.z, c0.w, c1.x, c1.y, c1.z, c1.w}, sn[8] = {s0.x, s0.y, s0.z, s0.w, s1.x, s1.y, s1.z, s1.w};
            v4u o1, o2;
#pragma unroll
            for (int w = 0; w < 4; ++w) { const float a0 = bflo(x1[w]), a1 = bfhi(x1[w]), b0 = bflo(x2[w]), b1 = bfhi(x2[w]);
                o1[w] = pk2(a0 * cs[2 * w] - b0 * sn[2 * w], a1 * cs[2 * w + 1] - b1 * sn[2 * w + 1]);
                o2[w] = pk2(b0 * cs[2 * w] + a0 * sn[2 * w], b1 * cs[2 * w + 1] + a1 * sn[2 * w + 1]); }
            x1 = o1; x2 = o2; }
        *(LAS v4u*)(T + (tok * TS + d0) * 2) = x1; *(LAS v4u*)(T + (tok * TS + 64 + d0) * 2) = x2; }
}

__device__ __forceinline__ void r1_phase(const Args& a, ldsp lds, int tid0, int lane, int wave) {
    const bf16* P = (const bf16*)(a.ws + WS_P); bf16* UB = (bf16*)(a.ws + WS_YB); const float* tab = (const float*)(a.ws + WS_ROPE);
    const ldsp Kt = lds, Vf = lds + TILE_B, Vb = lds + 2 * TILE_B;
    const int r0 = lane & 15, kq0 = lane >> 4;
    for (int u = blockIdx.x; u < 1280; u += gridDim.x) {
        const int cidx = u >> 2, h = u & 3, row0 = cidx * 128; const bool lat = cidx >= 64; const int tpos0 = lat ? ((cidx - 64) & 31) * 128 : 0;
        const float l2f = log2_sigmoid(a.in[10][h]), l2b = log2_sigmoid(a.in[10][4 + h]);
        const bf16* Pg = P + (size_t)row0 * NAB;
        int tid = tid0, r = r0, kq = kq0; asm volatile("" : "+v"(tid), "+v"(r), "+v"(kq));
        __syncthreads();
        load_rope_tile(Kt, Pg + 512 + h * 128, lat, tpos0, tab, tid);
#pragma unroll
        for (int rep = 0; rep < 4; ++rep) { const int it = tid + rep * NTHREADS, tok = it >> 4, ch = it & 15;
            const v4u x = *(const v4u*)(Pg + (size_t)tok * NAB + 1024 + h * 128 + ch * 8);
            const float sf = __builtin_amdgcn_exp2f((float)(127 - tok) * l2f), sb = __builtin_amdgcn_exp2f((float)tok * l2b);
            v4u of, ob;
#pragma unroll
            for (int w = 0; w < 4; ++w) { const float lo = bflo(x[w]), hi = bfhi(x[w]); of[w] = pk2(lo * sf, hi * sf); ob[w] = pk2(lo * sb, hi * sb); }
            *(LAS v4u*)(Vf + (tok * TS + ch * 8) * 2) = of; *(LAS v4u*)(Vb + (tok * TS + ch * 8) * 2) = ob; }
        __syncthreads();
        f32x4 acc[2][8];
#pragma unroll
        for (int d = 0; d < 2; ++d)
#pragma unroll
            for (int mt = 0; mt < 8; ++mt) acc[d][mt] = (f32x4){0.f, 0.f, 0.f, 0.f};
#pragma unroll
        for (int ks = 0; ks < 4; ++ks) { const int j0 = ks * 32 + kq * 8 + (r >> 2);
            const bf16x8 vfa = tr_frag(Vf + (j0 * TS + 16 * wave + 4 * (r & 3)) * 2, 8 * TS), vba = tr_frag(Vb + (j0 * TS + 16 * wave + 4 * (r & 3)) * 2, 8 * TS);
#pragma unroll
            for (int mt = 0; mt < 8; ++mt) { const bf16x8 ka = tr_frag(Kt + (j0 * TS + mt * 16 + 4 * (r & 3)) * 2, 8 * TS);
                acc[0][mt] = mfma16(ka, vfa, acc[0][mt]); acc[1][mt] = mfma16(ka, vba, acc[1][mt]); } }
#pragma unroll
        for (int d = 0; d < 2; ++d)
#pragma unroll
            for (int mt = 0; mt < 8; ++mt) { v2u w; w.x = pk2(acc[d][mt][0], acc[d][mt][1]); w.y = pk2(acc[d][mt][2], acc[d][mt][3]);
                *(v2u*)(UB + ((size_t)(u * 2 + d) * 128 + 16 * wave + r) * 128 + mt * 16 + 4 * kq) = w; }
    }
}

__device__ __forceinline__ void scan_item(const bf16* UB, bf16* SB, int cidx0, int n, int h, int dir, int e8, float dec, const float* S0, float* Sout) {
    const int dv = e8 >> 4, dk0 = (e8 & 15) * 8;
    float S[8];
#pragma unroll
    for (int i = 0; i < 8; ++i) S[i] = S0 ? S0[(size_t)(dk0 + i) * 128 + dv] : 0.f;
    for (int st = 0; st < n; ++st) { const int c = dir == 0 ? st : n - 1 - st; const size_t off = ((size_t)((cidx0 + c) * 4 + h) * 2 + dir) * 16384 + (size_t)e8 * 8;
        const v4u uu = *(const v4u*)(UB + off);
        v4u so; so.x = pk2(S[0], S[1]); so.y = pk2(S[2], S[3]); so.z = pk2(S[4], S[5]); so.w = pk2(S[6], S[7]);
        *(v4u*)(SB + off) = so;
#pragma unroll
        for (int w = 0; w < 4; ++w) { S[2 * w] = dec * S[2 * w] + bflo(uu[w]); S[2 * w + 1] = dec * S[2 * w + 1] + bfhi(uu[w]); } }
    if (Sout) {
#pragma unroll
        for (int i = 0; i < 8; ++i) Sout[(size_t)(dk0 + i) * 128 + dv] = S[i]; }
}
__device__ __forceinline__ void r2_phase(const Args& a, int tid) {
    const bf16* UB = (const bf16*)(a.ws + WS_YB); bf16* SB = (bf16*)(a.ws + WS_HB);
    const int NT = gridDim.x * NTHREADS;
    for (int t = blockIdx.x * NTHREADS + tid; t < 131072; t += NT) {
        const int e8 = t & 2047, dir = (t >> 11) & 1, h = (t >> 12) & 3, s = t >> 14;
        const float dec = exp2f(128.0f * log2_sigmoid(a.in[10][dir * 4 + h]));
        scan_item(UB, SB, 64 + s * 32, 32, h, dir, e8, dec, a.in[2] + (size_t)((s * 2 + dir) * 4 + h) * 16384, nullptr);
    }
    for (int t = blockIdx.x * NTHREADS + tid; t < 524288; t += NT) {
        const int e8 = t & 2047, dir = (t >> 11) & 1, h = (t >> 12) & 3, s = t >> 14;
        const float dec = exp2f(128.0f * log2_sigmoid(a.in[10][dir * 4 + h]));
        scan_item(UB, SB, s * 2, 2, h, dir, e8, dec, nullptr, a.out + (size_t)M * D + (size_t)((s * 2 + dir) * 4 + h) * 16384);
    }
}

__device__ __forceinline__ void r3_phase(const Args& a, ldsp lds, int tid0, int lane, int wave) {
    const bf16* P = (const bf16*)(a.ws + WS_P); const bf16* SB = (const bf16*)(a.ws + WS_HB); bf16* YB = (bf16*)(a.ws + WS_YB); const float* tab = (const float*)(a.ws + WS_ROPE);
    const ldsp Qt = lds, Kt = lds + TILE_B, Vt = lds + 2 * TILE_B, Pt = lds + 3 * TILE_B;
    const int r0 = lane & 15, kq0 = lane >> 4;
#ifndef NO_RET
    for (int u = blockIdx.x; u < 1280; u += gridDim.x) {
        const int cidx = u >> 2, h = u & 3, row0 = cidx * 128; const bool lat = cidx >= 64; const int tpos0 = lat ? ((cidx - 64) & 31) * 128 : 0;
        const float l2f = log2_sigmoid(a.in[10][h]), l2b = log2_sigmoid(a.in[10][4 + h]);
        const bf16* Pg = P + (size_t)row0 * NAB;
        int tid = tid0, r = r0, kq = kq0; asm volatile("" : "+v"(tid), "+v"(r), "+v"(kq));
        __syncthreads();
        load_rope_tile(Qt, Pg + h * 128, lat, tpos0, tab, tid);
        load_rope_tile(Kt, Pg + 512 + h * 128, lat, tpos0, tab, tid);
#pragma unroll
        for (int rep = 0; rep < 4; ++rep) { const int it = tid + rep * NTHREADS, tok = it >> 4, ch = it & 15;
            *(LAS v4u*)(Vt + (tok * TS + ch * 8) * 2) = *(const v4u*)(Pg + (size_t)tok * NAB + 1024 + h * 128 + ch * 8); }
        __syncthreads();
        const int il = 16 * wave + r;
        int ilq = il - 4 * kq; asm volatile("" : "+v"(ilq));
        bf16x8 qf[4];
#pragma unroll
        for (int ks = 0; ks < 4; ++ks) qf[ks] = *(const LAS bf16x8*)(Qt + (il * TS + ks * 32 + kq * 8) * 2);
#pragma unroll
        for (int nt = 0; nt < 8; ++nt) { f32x4 c = (f32x4){0.f, 0.f, 0.f, 0.f};
#pragma unroll
            for (int ks = 0; ks < 4; ++ks) { const bf16x8 kf = *(const LAS bf16x8*)(Kt + ((nt * 16 + r) * TS + ks * 32 + kq * 8) * 2); c = mfma16(kf, qf[ks], c); }
            float p[4];
#pragma unroll
            for (int e = 0; e < 4; ++e) { const float fd = (float)(ilq - (nt * 16 + e));
                const float dm = (fd == 0.0f) ? 2.0f : __builtin_amdgcn_exp2f(fmaxf(fd, 0.0f) * l2f + fmaxf(-fd, 0.0f) * l2b); p[e] = c[e] * dm; }
            v2u w; w.x = pk2(p[0], p[1]); w.y = pk2(p[2], p[3]);
            *(LAS v2u*)(Pt + (il * TS + nt * 16 + 4 * kq) * 2) = w; asm volatile("" ::: "memory"); }
        asm volatile("s_waitcnt lgkmcnt(0)" ::: "memory");
        f32x4 oi[8];
#pragma unroll
        for (int nt = 0; nt < 8; ++nt) oi[nt] = (f32x4){0.f, 0.f, 0.f, 0.f};
#pragma unroll
        for (int ks = 0; ks < 4; ++ks) { const bf16x8 pf = *(const LAS bf16x8*)(Pt + (il * TS + ks * 32 + kq * 8) * 2); const int j0 = ks * 32 + kq * 8 + (r >> 2);
#pragma unroll
            for (int nt = 0; nt < 8; ++nt) { const bf16x8 vf = tr_frag(Vt + (j0 * TS + nt * 16 + 4 * (r & 3)) * 2, 8 * TS); oi[nt] = mfma16(pf, vf, oi[nt]); }
            asm volatile("" ::: "memory"); }
        int iq = 16 * wave + 4 * kq; asm volatile("" : "+v"(iq));
#pragma unroll
        for (int dir = 0; dir < 2; ++dir) {
            const bf16* Sp = SB + (size_t)(u * 2 + dir) * 16384 + r * 128 + kq * 8;
            float cr[4];
#pragma unroll
            for (int e = 0; e < 4; ++e) cr[e] = dir == 0 ? __builtin_amdgcn_exp2f((float)(iq + e + 1) * l2f) : __builtin_amdgcn_exp2f((float)(128 - iq - e) * l2b);
            bf16x8 sfr[2][4];
#pragma unroll
            for (int ks = 0; ks < 4; ++ks) sfr[0][ks] = *(const bf16x8*)(Sp + ks * 32);
#pragma unroll
            for (int nt = 0; nt < 8; ++nt) {
                if (nt < 7) {
#pragma unroll
                    for (int ks = 0; ks < 4; ++ks) sfr[(nt + 1) & 1][ks] = *(const bf16x8*)(Sp + (nt + 1) * 2048 + ks * 32); }
                f32x4 t = (f32x4){0.f, 0.f, 0.f, 0.f};
#pragma unroll
                for (int ks = 0; ks < 4; ++ks) t = mfma16(qf[ks], sfr[nt & 1][ks], t);
#pragma unroll
                for (int e = 0; e < 4; ++e) oi[nt][e] += cr[e] * t[e];
                asm volatile("" ::: "memory");
            }
        }
        float ss[4];
#pragma unroll
        for (int e = 0; e < 4; ++e) { float s = 0.f;
#pragma unroll
            for (int nt = 0; nt < 8; ++nt) s += oi[nt][e] * oi[nt][e];
            s += __shfl_xor(s, 1); s += __shfl_xor(s, 2); s += __shfl_xor(s, 4); s += __shfl_xor(s, 8);
            ss[e] = rsqrtf(s * (1.0f / 128.0f) + EPS); }
#pragma unroll
        for (int nt = 0; nt < 8; ++nt)
#pragma unroll
            for (int e = 0; e < 4; ++e) *(LAS bf16*)(Pt + ((16 * wave + 4 * kq + e) * TS + nt * 16 + r) * 2) = (bf16)(pk2(oi[nt][e] * ss[e], 0.f) & 0xffffu);
        asm volatile("s_waitcnt lgkmcnt(0)" ::: "memory");
        { const int ln = kq * 16 + r, rw = ln >> 2, c4 = ln & 3, lrow = 16 * wave + rw; const float* rg = a.in[11] + h * 128 + c4 * 32;
#pragma unroll
            for (int k = 0; k < 4; ++k) { const v4u o8 = *(const LAS v4u*)(Pt + (lrow * TS + c4 * 32 + k * 8) * 2); const v4u g8 = *(const v4u*)(Pg + (size_t)lrow * NAB + 1536 + h * 128 + c4 * 32 + k * 8);
                const f32x4 r0 = *(const f32x4*)(rg + k * 8), r1 = *(const f32x4*)(rg + k * 8 + 4); const float rgv[8] = {r0.x, r0.y, r0.z, r0.w, r1.x, r1.y, r1.z, r1.w};
                v4u y;
#pragma unroll
                for (int w = 0; w < 4; ++w) { const float g0 = bflo(g8[w]), g1 = bfhi(g8[w]);
                    y[w] = pk2(g0 * pg8::fast_sigmoid(g0) * bflo(o8[w]) * rgv[2 * w], g1 * pg8::fast_sigmoid(g1) * bfhi(o8[w]) * rgv[2 * w + 1]); }
                *(v4u*)(YB + (size_t)(row0 + lrow) * D + h * 128 + c4 * 32 + k * 8) = y; } }
    }
#endif
#ifndef NO_CONV
    {
        const float* cw = a.in[12]; const float* cbv = a.in[13];
        const int NT = gridDim.x * NTHREADS;
        for (int it = blockIdx.x * NTHREADS + tid0; it < M * 64; it += NT) { const int m = it >> 6, c0 = (it & 63) * 8;
            const int slen = m < MCTX ? 256 : 4096, pos = m < MCTX ? (m & 255) : ((m - MCTX) & 4095);
            const bf16* Pm = P + (size_t)m * NAB;
            const v4u bg = *(const v4u*)(Pm + 2048 + c0), cg0 = *(const v4u*)(Pm + 2560 + c0), xc0 = *(const v4u*)(Pm + 3072 + c0);
            v4u cgm = (v4u){0u, 0u, 0u, 0u}, xcm = cgm, cgp = cgm, xcp = cgm;
            if (pos > 0) { cgm = *(const v4u*)(Pm - NAB + 2560 + c0); xcm = *(const v4u*)(Pm - NAB + 3072 + c0); }
            if (pos < slen - 1) { cgp = *(const v4u*)(Pm + NAB + 2560 + c0); xcp = *(const v4u*)(Pm + NAB + 3072 + c0); }
            float w0[8], w1[8], w2[8], bb[8];
#pragma unroll
            for (int q = 0; q < 2; ++q) { const f32x4 t0 = *(const f32x4*)(cw + c0 + 4 * q), t1 = *(const f32x4*)(cw + 512 + c0 + 4 * q), t2 = *(const f32x4*)(cw + 1024 + c0 + 4 * q), t3 = *(const f32x4*)(cbv + c0 + 4 * q);
#pragma unroll
                for (int j = 0; j < 4; ++j) { w0[4 * q + j] = t0[j]; w1[4 * q + j] = t1[j]; w2[4 * q + j] = t2[j]; bb[4 * q + j] = t3[j]; } }
            v4u y;
#pragma unroll
            for (int w = 0; w < 4; ++w) {
                const float zm0 = bflo(cgm[w]) * bflo(xcm[w]), zm1 = bfhi(cgm[w]) * bfhi(xcm[w]);
                const float z00 = bflo(cg0[w]) * bflo(xc0[w]), z01 = bfhi(cg0[w]) * bfhi(xc0[w]);
                const float zp0 = bflo(cgp[w]) * bflo(xcp[w]), zp1 = bfhi(cgp[w]) * bfhi(xcp[w]);
                const float y0 = bflo(bg[w]) * (w0[2 * w] * zm0 + w1[2 * w] * z00 + w2[2 * w] * zp0 + bb[2 * w]);
                const float y1 = bfhi(bg[w]) * (w0[2 * w + 1] * zm1 + w1[2 * w + 1] * z01 + w2[2 * w + 1] * zp1 + bb[2 * w + 1]);
                y[w] = pk2(y0, y1); }
            *(v4u*)(YB + (size_t)m * D + 512 + c0) = y; }
    }
#endif
}

__device__ __forceinline__ void spatial_phase(const Args& a, ldsp lds, int tid0, int lane, int wave) {
    const bf16* Z = (const bf16*)(a.ws + WS_P); bf16* YB = (bf16*)(a.ws + WS_YB); const float* vsq = (const float*)(a.ws + WS_VSQ);
    const float* w_s = a.in[17]; const float* b_s = a.in[18]; const float* vg = a.in[16];
    const ldsp At = lds, Vt = lds + TILE_B; LAS float* rs = (LAS float*)(lds + TILE_B + 128 * VS * 2);
    const int r0 = lane & 15, kq0 = lane >> 4;
    for (int u = blockIdx.x; u < 1280; u += gridDim.x) {
        const int cidx = u >> 2, g = u & 3, row0 = cidx * 128;
        int tid = tid0, r = r0, kq = kq0; asm volatile("" : "+v"(tid), "+v"(r), "+v"(kq));
        __syncthreads();
        if (tid < 128) { const f32x4* vp = (const f32x4*)(vsq + (size_t)(row0 + tid) * 16); const f32x4 s0 = vp[0], s1 = vp[1], s2 = vp[2], s3 = vp[3];
            const float s = ((s0.x + s0.y) + (s0.z + s0.w)) + ((s1.x + s1.y) + (s1.z + s1.w)) + ((s2.x + s2.y) + (s2.z + s2.w)) + ((s3.x + s3.y) + (s3.z + s3.w));
            rs[tid] = rsqrtf(s * (1.0f / 1024.0f) + EPS); }
#pragma unroll
        for (int rep = 0; rep < 8; ++rep) { const int it = tid + rep * NTHREADS, q = it >> 5, c = it & 31;
            *(LAS v4u*)(Vt + (q * VS + c * 8) * 2) = *(const v4u*)(Z + (size_t)(row0 + q) * NC + 1024 + g * 256 + c * 8); }
        __syncthreads();
#pragma unroll
        for (int rep = 0; rep < 4; ++rep) { const int it = tid + rep * NTHREADS, p = it >> 4, c = it & 15;
            const f32x4 w0 = *(const f32x4*)(w_s + (size_t)(g * 128 + p) * 128 + c * 8), w1 = *(const f32x4*)(w_s + (size_t)(g * 128 + p) * 128 + c * 8 + 4);
            const LAS float* rq = rs + c * 8;
            v4u o; o.x = pk2(w0.x * rq[0], w0.y * rq[1]); o.y = pk2(w0.z * rq[2], w0.w * rq[3]); o.z = pk2(w1.x * rq[4], w1.y * rq[5]); o.w = pk2(w1.z * rq[6], w1.w * rq[7]);
            *(LAS v4u*)(At + (p * TS + c * 8) * 2) = o; }
        __syncthreads();
        f32x4 acc[2][8];
#pragma unroll
        for (int n2 = 0; n2 < 2; ++n2)
#pragma unroll
            for (int mt = 0; mt < 8; ++mt) acc[n2][mt] = (f32x4){0.f, 0.f, 0.f, 0.f};
#pragma unroll
        for (int ks = 0; ks < 4; ++ks) { const int q0 = ks * 32 + kq * 8 + (r >> 2);
            const bf16x8 va0 = tr_frag(Vt + (q0 * VS + 32 * wave + 4 * (r & 3)) * 2, 8 * VS), va1 = tr_frag(Vt + (q0 * VS + 32 * wave + 16 + 4 * (r & 3)) * 2, 8 * VS);
#pragma unroll
            for (int mt = 0; mt < 8; ++mt) { const bf16x8 wf = *(const LAS bf16x8*)(At + ((mt * 16 + r) * TS + ks * 32 + kq * 8) * 2);
                acc[0][mt] = mfma16(va0, wf, acc[0][mt]); acc[1][mt] = mfma16(va1, wf, acc[1][mt]); } }
#pragma unroll
        for (int n2 = 0; n2 < 2; ++n2) { const int gch = g * 256 + 32 * wave + 16 * n2 + 4 * kq; const f32x4 vg4 = *(const f32x4*)(vg + gch);
#pragma unroll
            for (int mt = 0; mt < 8; ++mt) { const int p = mt * 16 + r; const float bsp = b_s[g * 128 + p];
                const v2u uu = *(const v2u*)(Z + (size_t)(row0 + p) * NC + gch);
                const float s0 = acc[n2][mt][0] * vg4.x + bsp, s1 = acc[n2][mt][1] * vg4.y + bsp, s2 = acc[n2][mt][2] * vg4.z + bsp, s3 = acc[n2][mt][3] * vg4.w + bsp;
                v2u y; y.x = pk2(bflo(uu.x) * s0, bfhi(uu.x) * s1); y.y = pk2(bflo(uu.y) * s2, bfhi(uu.y) * s3);
                *(v2u*)(YB + (size_t)(row0 + p) * D + gch) = y; } }
    }
}

__device__ __forceinline__ void shw_phase(const Args& a, int lane, int wave) {
    unsigned char* ws = a.ws; const float* mod0 = (const float*)(ws + WS_MOD); const float* mod1 = mod0 + NCOND * MODW; float* shw = (float*)(ws + WS_SHW);
    const int gw = blockIdx.x * NWAVES + wave, NGW = gridDim.x * NWAVES;
    for (int rw = gw; rw < 2 * NGU + NC; rw += NGW) {
        const bf16* wrow; const float* sh; float* dst; int nb, n;
        if (rw < NGU) { n = rw; wrow = (const bf16*)(ws + WS_WGU) + (size_t)n * 1024; sh = mod0 + 3072; dst = shw; nb = NGU; }
        else if (rw < NGU + NC) { n = rw - NGU; wrow = (const bf16*)(ws + WS_WINC) + (size_t)n * 1024; sh = mod1; dst = shw + NCOND * NGU; nb = NC; }
        else { n = rw - NGU - NC; wrow = (const bf16*)(ws + WS_WGU) + (size_t)(NGU + n) * 1024; sh = mod1 + 3072; dst = shw + NCOND * (NGU + NC); nb = NGU; }
        const v4u w0 = *(const v4u*)(wrow + lane * 16), w1 = *(const v4u*)(wrow + lane * 16 + 8);
        float wf[16];
#pragma unroll
        for (int q = 0; q < 4; ++q) { wf[2 * q] = bflo(w0[q]); wf[2 * q + 1] = bfhi(w0[q]); wf[8 + 2 * q] = bflo(w1[q]); wf[8 + 2 * q + 1] = bfhi(w1[q]); }
#pragma unroll
        for (int cb = 0; cb < NCOND; ++cb) { const f32x4* sp = (const f32x4*)(sh + (size_t)cb * MODW + lane * 16); float s = 0.f;
#pragma unroll
            for (int q = 0; q < 4; ++q) { const f32x4 t = sp[q]; s += (t.x * wf[4 * q] + t.y * wf[4 * q + 1]) + (t.z * wf[4 * q + 2] + t.w * wf[4 * q + 3]); }
            s = wave_sum(s); if (lane == 0) dst[(size_t)cb * nb + n] = s; }
    }
}
#define XB_TMO      128
#define XB_XCNT(j)  (256  + 64 * (j))
#define XB_XSUB(j)  (1280 + 64 * (j))
#define XB_XGEN(j)  (2304 + 64 * (j))
#define XB_TOP      3328
#define XB_TOPGEN   3392
#define XCD_BAR_WORDS 3456
#define XB_SPIN_CAP (1u << 18)

__device__ __forceinline__ unsigned xb_ld(unsigned* p)              { return __hip_atomic_load(p, __ATOMIC_RELAXED, __HIP_MEMORY_SCOPE_AGENT); }
__device__ __forceinline__ unsigned xb_add(unsigned* p, unsigned v) { return __hip_atomic_fetch_add(p, v, __ATOMIC_RELAXED, __HIP_MEMORY_SCOPE_AGENT); }
__device__ __forceinline__ unsigned xb_xcc_id() { return (unsigned)__builtin_amdgcn_s_getreg((3 << 11) | 20) & 0xFu; }
#define XB_SPIN(cond, bar) do { unsigned _sp = 0; while (cond) { __builtin_amdgcn_s_sleep(1); \
    if ((++_sp & 255u) == 0u) { if (xb_ld(&(bar)[XB_TMO])) break; if (_sp > XB_SPIN_CAP) { atomicAdd(&(bar)[XB_TMO], 1u); break; } } } } while (0)

struct XcdBarrier {
    unsigned* bar; unsigned x;
    volatile LAS unsigned* st;
};

__device__ __forceinline__ XcdBarrier xcd_barrier_post(unsigned* bar, volatile LAS unsigned* st) {
    XcdBarrier b; b.bar = bar; b.x = xb_xcc_id(); b.st = st;
    if (threadIdx.x == 0) (void)xb_add(&bar[XB_XCNT(b.x)], 1u);
    return b;
}
__device__ __forceinline__ void xcd_barrier_complete(unsigned* bar, unsigned x, unsigned& nloc, unsigned& nx) {
    const unsigned G = gridDim.x * gridDim.y * gridDim.z;
    unsigned sum, cnt, mine, sp = 0u;
    for (;;) {
        sum = 0u; cnt = 0u; mine = 0u;
#pragma unroll
        for (unsigned j = 0; j < 16; ++j) { const unsigned c = xb_ld(&bar[XB_XCNT(j)]); sum += c; cnt += (c > 0u) ? 1u : 0u; mine = (j == x) ? c : mine; }
        if (sum == G) break;
        __builtin_amdgcn_s_sleep(1);
        if ((++sp & 255u) == 0u) { if (xb_ld(&bar[XB_TMO])) break; if (sp > XB_SPIN_CAP) { atomicAdd(&bar[XB_TMO], 1u); break; } }
    }
    nloc = mine > 0u ? mine : 1u; nx = cnt > 0u ? cnt : 1u;
}

__device__ __forceinline__ void xcd_barrier(const XcdBarrier& b) {
    asm volatile("s_waitcnt vmcnt(0)" ::: "memory");
    __syncthreads();
    if (threadIdx.x == 0) {
        unsigned* bar = b.bar;
        __builtin_amdgcn_s_waitcnt(0);
        unsigned nloc = b.st[0], nx = b.st[1];
        if (nloc == 0u) { xcd_barrier_complete(bar, b.x, nloc, nx); b.st[0] = nloc; b.st[1] = nx; }
        const unsigned old = xb_add(&bar[XB_XSUB(b.x)], 1u);
        const unsigned gen = old / nloc;
        if (old + 1u == (gen + 1u) * nloc) {
            __builtin_amdgcn_fence(__ATOMIC_RELEASE, "agent");
            asm volatile("s_waitcnt vmcnt(0)" ::: "memory");
            const unsigned og = xb_add(&bar[XB_TOP], 1u);
            const unsigned tg = og / nx;
            if (og + 1u == (tg + 1u) * nx) xb_add(&bar[XB_TOPGEN], 1u);
            else XB_SPIN(xb_ld(&bar[XB_TOPGEN]) == tg, bar);
            __builtin_amdgcn_fence(__ATOMIC_ACQUIRE, "agent");
            xb_add(&bar[XB_XGEN(b.x)], 1u);
            asm volatile("s_waitcnt vmcnt(0)" ::: "memory");
        } else {
            XB_SPIN(xb_ld(&bar[XB_XGEN(b.x)]) == gen, bar);
            __builtin_amdgcn_fence(__ATOMIC_ACQUIRE, "agent");
            asm volatile("s_waitcnt vmcnt(0)" ::: "memory");
        }
    }
    __syncthreads();
}

__global__ void __launch_bounds__(NTHREADS, 2) mega_fwd(Args a) {
    extern __shared__ __attribute__((aligned(16))) unsigned char lds_raw[];
    const ldsp lds = (ldsp)lds_raw;
    const int tid = threadIdx.x, lane = tid & 63, wave = __builtin_amdgcn_readfirstlane(tid >> 6);
    unsigned char* ws = a.ws;
    float* mod0 = (float*)(ws + WS_MOD); float* mod1 = mod0 + NCOND * MODW;
    bf16* HB = (bf16*)(ws + WS_HB); bf16* YB = (bf16*)(ws + WS_YB); bf16* PB = (bf16*)(ws + WS_P);
    const int G = gridDim.x, bx = blockIdx.x;
#if ONE_LAUNCH
    volatile LAS unsigned* misc = (volatile LAS unsigned*)(lds + MISC_OFF);
    if (tid < 16) misc[tid] = 0u;
    __syncthreads();
    const XcdBarrier xbar = xcd_barrier_post((unsigned*)(ws + WS_BAR), misc);
#endif
#define IN(k) (((PH_MASK >> (k)) & 1) && a.ph_lo <= (k) && (k) < a.ph_hi)
#define INN(k) (a.ph_lo <= (k) && (k) < a.ph_hi)
#if ONE_LAUNCH
#define SEAM(k) do { if (INN(k) && INN((k) + 1)) { if ((k) == 0) cg::this_grid().sync(); else xcd_barrier(xbar); } } while (0)
#else
#define SEAM(k) do { } while (0)
#endif
#define GEMM(EpiT, Aop, Bop, Nn, Kk, Eobj) do { pg8::Gemm g_{(const pg8::bf16_t*)(Aop), (const pg8::bf16_t*)(Bop), M, (Nn), (Kk)}; pg8::StaticOrder S_; S_.init(M, (Nn), G, bx); \
        pg8::gemm_phase<EpiT, pg8::StaticOrder, true, true>(lds, g_, S_, (Eobj)); } while (0)

    if (IN(0)) p0_prologue(a, lds, tid, lane, wave);
    SEAM(0);
    if (IN(1)) { norm_pass<true>(a, a.in[7], mod0, 0, 1024, HB, lane, wave); shw_phase(a, lane, wave); }
    SEAM(1);
    if (IN(2)) { pg8::EpiStoreBf16 E{PB, NAB}; GEMM(pg8::EpiStoreBf16, HB, ws + WS_WAB, NAB, 1024, E); }
    SEAM(2);
    if (IN(3)) r1_phase(a, lds, tid, lane, wave);
    SEAM(3);
    if (IN(4)) r2_phase(a, tid);
    SEAM(4);
    if (IN(5)) r3_phase(a, lds, tid, lane, wave);
    SEAM(5);
    float* rsq = (float*)(ws + WS_RSQ); const float* shw = (const float*)(ws + WS_SHW);
    if (IN(6)) { pg8::EpiResidNorm E{a.in[0], a.in[1], a.out, mod0 + 2048, HB, a.in[8], mod0 + 4096, rsq}; GEMM(pg8::EpiResidNorm, YB, ws + WS_WOAB, 1024, 1024, E); }
    SEAM(6);
    if (IN(8)) { pg8::EpiSwiglu E{PB, FF, rsq, shw, NGU}; GEMM(pg8::EpiSwiglu, HB, ws + WS_WGU, NGU, 1024, E); }
    SEAM(8);
    if (IN(9)) { pg8::EpiResidNorm E{a.out, a.out + (size_t)MCTX * D, a.out, mod0 + 5120, HB, a.in[7] + D, mod1 + 1024, rsq}; GEMM(pg8::EpiResidNorm, PB, ws + WS_WDN, 1024, FF, E); }
    SEAM(9);
    if (IN(11)) { pg8::EpiGeluSq E{PB, NC, (float*)(ws + WS_VSQ), 4, rsq, shw + NCOND * NGU, NC}; GEMM(pg8::EpiGeluSq, HB, ws + WS_WINC, NC, 1024, E); }
    SEAM(11);
    if (IN(12)) spatial_phase(a, lds, tid, lane, wave);
    SEAM(12);
    if (IN(13)) { pg8::EpiResidNorm E{a.out, a.out + (size_t)MCTX * D, a.out, mod1 + 2048, HB, a.in[8] + D, mod1 + 4096, rsq}; GEMM(pg8::EpiResidNorm, YB, ws + WS_WOC, 1024, 1024, E); }
    SEAM(13);
    if (IN(15)) { pg8::EpiSwiglu E{PB, FF, rsq, shw + NCOND * (NGU + NC), NGU}; GEMM(pg8::EpiSwiglu, HB, ws + WS_WGU + (size_t)NGU * 1024 * 2, NGU, 1024, E); }
    SEAM(15);
    if (IN(16)) { pg8::EpiResid E{a.out, a.out + (size_t)MCTX * D, a.out, mod1 + 5120}; GEMM(pg8::EpiResid, PB, ws + WS_WDN + (size_t)1024 * FF * 2, 1024, FF, E); }
    SEAM(16);
    if (IN(17)) final_norm(a, a.in[23], lane, wave);
#undef IN
#undef SEAM
#undef GEMM
}

extern "C" void kernel_launch(void* const* d_in, const int* in_sizes, int n_in, void* d_out, int out_size, void* d_ws, size_t ws_size, hipStream_t stream) {
    static int grid = 0;
    if (grid == 0) {
        if (n_in != 24 || ws_size < WS_END) { fprintf(stderr, "kernel_launch: unexpected n_in %d / ws_size %zu\n", n_in, ws_size); grid = -1; return; }
        int dev = 0, cus = 0;
        if (hipGetDevice(&dev) != hipSuccess || hipDeviceGetAttribute(&cus, hipDeviceAttributeMultiprocessorCount, dev) != hipSuccess) { grid = -1; return; }
        if (hipFuncSetAttribute((const void*)mega_fwd, hipFuncAttributeMaxDynamicSharedMemorySize, LDS_BYTES) != hipSuccess) { fprintf(stderr, "kernel_launch: hipFuncSetAttribute failed\n"); grid = -1; return; }
        (void)hipGetLastError();
        grid = cus;
    }
    if (grid < 0) return;
    Args a{};
    for (int i = 0; i < 24; ++i) a.in[i] = (const float*)d_in[i];
    a.out = (float*)d_out; a.ws = (unsigned char*)d_ws;
#if ONE_LAUNCH
    if (hipMemsetAsync((char*)d_ws + WS_BAR, 0, XCD_BAR_WORDS * 4, stream) != hipSuccess) { fprintf(stderr, "kernel_launch: hipMemsetAsync failed\n"); return; }
    a.ph_lo = 0; a.ph_hi = N_PHASES;
    void* args[] = {&a};
    hipError_t e = hipLaunchCooperativeKernel((const void*)mega_fwd, dim3(grid), dim3(NTHREADS), args, LDS_BYTES, stream);
    if (e != hipSuccess) fprintf(stderr, "cooperative launch failed: %s (grid %d)\n", hipGetErrorString(e), grid);
#else
    for (int p = 0; p < N_PHASES; ++p) { a.ph_lo = p; a.ph_hi = p + 1; hipLaunchKernelGGL(mega_fwd, dim3(grid), dim3(NTHREADS), LDS_BYTES, stream, a); }
#endif
}
```

```cpp
#include <hip/hip_runtime.h>
#include <hip/hip_cooperative_groups.h>
#include <cstdio>
#include <cstdint>
namespace cg = cooperative_groups;
#ifndef PG8_AUX_A
#define PG8_AUX_A 0
#endif
#ifndef PG8_AUX_B
#define PG8_AUX_B 0
#endif
#ifndef PG8_PFD
#define PG8_PFD 5
#endif
namespace pg8 {
#define PG8_LAS __attribute__((address_space(3)))
typedef unsigned short bf16_t;
typedef short bf16x8 __attribute__((ext_vector_type(8)));
typedef float f32x4 __attribute__((ext_vector_type(4)));
typedef unsigned u32x4 __attribute__((ext_vector_type(4)));
typedef unsigned u32x2 __attribute__((ext_vector_type(2)));
constexpr int BM = 256, BK = 64, HALF = 128, HTB = HALF * BK * 2  , STAGE_BYTES = 8 * HTB, NXCD = 8, WGM = 4;

__host__ __device__ __forceinline__ int lds_byte(int r, int c) { const int st = (r >> 4) * 2 + (c >> 5), rr = r & 15, cc = c & 31, ob = rr * 64 + cc * 2; return st * 1024 + (ob ^ (((ob >> 9) & 1) << 5)); }
__host__ __device__ __forceinline__ void stage_rc(int b, int& R, int& C) { const int st = b / 1024, sb = b % 1024, swz = sb ^ (((sb >> 9) & 1) << 5); R = (st >> 1) * 16 + swz / 64; C = (st & 1) * 32 + (swz % 64) / 2; }
__host__ __device__ __forceinline__ int perm32(int rho) { const int n = rho >> 4, i = rho & 15; return 8 * (i >> 2) + 4 * n + (i & 3); }

__host__ __device__ __forceinline__ int invperm32(int x) { return ((x >> 2) & 1) * 16 + (x >> 3) * 4 + (x & 3); }
__host__ __device__ __forceinline__ size_t tiled_off(int m, int k, int K) { return ((((size_t)(m >> 8) * (size_t)(K >> 6)) + (size_t)(k >> 6)) << 14) + (size_t)(((m >> 7) & 1) << 13) + (size_t)(lds_byte(m & 127, k & 63) >> 1); }
__host__ __device__ __forceinline__ size_t tiled_off_b(int n, int k, int K) { const int r = n & 127, R = (r & ~31) + invperm32(r & 31); return ((((size_t)(n >> 8) * (size_t)(K >> 6)) + (size_t)(k >> 6)) << 14) + (size_t)(((n >> 7) & 1) << 13) + (size_t)(lds_byte(R, k & 63) >> 1); }
struct Unit { int pm, pn; };
struct Gemm { const bf16_t* A; const bf16_t* Bt; int M, N, K; };

struct StaticOrder {
    int nM, nN, nwg, G, c;
    __host__ __device__ void init(int M, int N, int G_, int c_) { nM = M / BM; nN = N / BM; nwg = nM * nN; G = G_; c = c_; }
    __host__ __device__ bool next(int i, Unit& u) const {
        const long L = (long)i * G + c; if (L >= nwg) return false;
        int wgid = (int)L; { const int q = nwg / NXCD, r = nwg % NXCD, xcd = wgid % NXCD, off = wgid / NXCD; wgid = (xcd < r ? xcd * (q + 1) : r * (q + 1) + (xcd - r) * q) + off; }
        const int nig = WGM * nN, gid = wgid / nig, fm = gid * WGM, gsz = (nM - fm) < WGM ? (nM - fm) : WGM;
        u.pm = fm + ((wgid % nig) % gsz); u.pn = (wgid % nig) / gsz; return true;
    }
    __device__ __forceinline__ void a_ready(const Unit&) const {}
    __device__ __forceinline__ void done(const Unit&) const {}
};

typedef float f32x2_cv __attribute__((ext_vector_type(2))); typedef __bf16 bf16x2_cv __attribute__((ext_vector_type(2)));
__device__ __forceinline__ unsigned cvt_pk_bf16(float lo, float hi) { const f32x2_cv v = {lo, hi}; const bf16x2_cv b = __builtin_convertvector(v, bf16x2_cv); return __builtin_bit_cast(unsigned, b); }
typedef float f32x2 __attribute__((ext_vector_type(2)));
__device__ __forceinline__ float fast_sigmoid(float x) { return __builtin_amdgcn_rcpf(1.0f + __builtin_amdgcn_exp2f(-1.4426950408889634f * x)); }
struct EpiStoreBf16 {
    static constexpr bool PERM = true, AFTER_DRAIN = false;
    bf16_t* O; int ldc;
    __device__ __forceinline__ void operator()(const f32x4 (&acc)[2][2][4][2], const Unit& u, int wr, int wc, int fr, int fq) const {
        const int row0 = u.pm * BM + wr * 64 + fr, col0 = u.pn * BM + wc * 32 + 8 * fq;
#pragma unroll
        for (int ai = 0; ai < 2; ++ai)
#pragma unroll
            for (int m = 0; m < 4; ++m) { bf16_t* rowp = O + (size_t)(row0 + ai * HALF + m * 16) * ldc + col0;
#pragma unroll
                for (int bj = 0; bj < 2; ++bj) { const f32x4 v0 = acc[ai][bj][m][0], v1 = acc[ai][bj][m][1];
                    u32x4 w; w.x = cvt_pk_bf16(v0[0], v0[1]); w.y = cvt_pk_bf16(v0[2], v0[3]); w.z = cvt_pk_bf16(v1[0], v1[1]); w.w = cvt_pk_bf16(v1[2], v1[3]);
                    *(u32x4*)(rowp + bj * HALF) = w; } }
    }
};
__device__ __forceinline__ void load_rstd(const float* rsq, int row0, int fq, float (&rstd)[2][4]) {
#pragma unroll
    for (int ai = 0; ai < 2; ++ai)
#pragma unroll
        for (int m = 0; m < 4; ++m) { const f32x4 p = *(const f32x4*)(rsq + (size_t)(row0 + ai * HALF + m * 16) * 16 + 4 * fq); float s = (p[0] + p[1]) + (p[2] + p[3]);
            s += __shfl_xor(s, 16); s += __shfl_xor(s, 32); rstd[ai][m] = rsqrtf(s * (1.0f / 1024.0f) + 1e-6f); }
}
struct EpiGeluSq {
    static constexpr bool PERM = true, AFTER_DRAIN = false;
    bf16_t* O; int ldc; float* vsq; int pn_v; const float* rsq; const float* bias; int nbias;
    __device__ __forceinline__ void operator()(const f32x4 (&acc)[2][2][4][2], const Unit& u, int wr, int wc, int fr, int fq) const {
        const int row0 = u.pm * BM + wr * 64 + fr, col0 = u.pn * BM + wc * 32 + 8 * fq;
        const int cb = u.pm < 32 ? 0 : 1 + ((u.pm - 32) >> 4);
        float rstd[2][4]; load_rstd(rsq, row0, fq, rstd);
        f32x4 bv[2][2];
#pragma unroll
        for (int bj = 0; bj < 2; ++bj)
#pragma unroll
            for (int n = 0; n < 2; ++n) bv[bj][n] = *(const f32x4*)(bias + (size_t)cb * nbias + col0 + bj * HALF + 4 * n);
#pragma unroll
        for (int ai = 0; ai < 2; ++ai)
#pragma unroll
            for (int m = 0; m < 4; ++m) { const int row = row0 + ai * HALF + m * 16; bf16_t* rowp = O + (size_t)row * ldc + col0; float ss = 0.f;
#pragma unroll
                for (int bj = 0; bj < 2; ++bj) { f32x4 v[2];
#pragma unroll
                    for (int n = 0; n < 2; ++n)
#pragma unroll
                        for (int j = 0; j < 4; ++j) { const float x = acc[ai][bj][m][n][j] * rstd[ai][m] + bv[bj][n][j];
                            const float gl = x * __builtin_amdgcn_rcpf(1.0f + __builtin_amdgcn_exp2f(x * (x * x * -0.10294324f + -2.3022082f))); v[n][j] = gl; ss += gl * gl; }
                    u32x4 w; w.x = cvt_pk_bf16(v[0][0], v[0][1]); w.y = cvt_pk_bf16(v[0][2], v[0][3]); w.z = cvt_pk_bf16(v[1][0], v[1][1]); w.w = cvt_pk_bf16(v[1][2], v[1][3]);
                    *(u32x4*)(rowp + bj * HALF) = w; }
                ss += __shfl_xor(ss, 16); ss += __shfl_xor(ss, 32);
                if (u.pn >= pn_v && fq == 0) vsq[(size_t)row * 16 + (u.pn - pn_v) * 4 + wc] = ss; }
    }
};
struct EpiSwiglu {
    static constexpr bool PERM = true, AFTER_DRAIN = false;
    bf16_t* O; int ldc; const float* rsq; const float* bias; int nbias;
    __device__ __forceinline__ void operator()(const f32x4 (&acc)[2][2][4][2], const Unit& u, int wr, int wc, int fr, int fq) const {
        const int row0 = u.pm * BM + wr * 64 + fr, col0 = u.pn * HALF + wc * 32 + 8 * fq;
        const int cb = u.pm < 32 ? 0 : 1 + ((u.pm - 32) >> 4);
        float rstd[2][4]; load_rstd(rsq, row0, fq, rstd);
        f32x4 bv[2][2];
#pragma unroll
        for (int bj = 0; bj < 2; ++bj)
#pragma unroll
            for (int n = 0; n < 2; ++n) bv[bj][n] = *(const f32x4*)(bias + (size_t)cb * nbias + u.pn * BM + bj * HALF + wc * 32 + 8 * fq + 4 * n);
#pragma unroll
        for (int ai = 0; ai < 2; ++ai)
#pragma unroll
            for (int m = 0; m < 4; ++m) { bf16_t* rowp = O + tiled_off(row0 + ai * HALF + m * 16, col0, ldc); f32x4 v[2];
#pragma unroll
                for (int n = 0; n < 2; ++n)
#pragma unroll
                    for (int j = 0; j < 4; ++j) { const float g = acc[ai][0][m][n][j] * rstd[ai][m] + bv[0][n][j], up = acc[ai][1][m][n][j] * rstd[ai][m] + bv[1][n][j]; v[n][j] = g * fast_sigmoid(g) * up; }
                u32x4 w; w.x = cvt_pk_bf16(v[0][0], v[0][1]); w.y = cvt_pk_bf16(v[0][2], v[0][3]); w.z = cvt_pk_bf16(v[1][0], v[1][1]); w.w = cvt_pk_bf16(v[1][2], v[1][3]);
                *(u32x4*)rowp = w; }
    }
};
template <bool F32BASE, bool NORM> struct EpiResidB {
    static constexpr bool PERM = true, AFTER_DRAIN = false;
    const float* b0; const float* b1; const bf16_t* XI; bf16_t* XO; const float* gate; bf16_t* A; const float* gn; const float* sc; float* rsq;
    __device__ __forceinline__ void operator()(const f32x4 (&acc)[2][2][4][2], const Unit& u, int wr, int wc, int fr, int fq) const {
        const int cb = u.pm < 32 ? 0 : 1 + ((u.pm - 32) >> 4);
        const int row0 = u.pm * BM + wr * 64 + fr, col0 = u.pn * BM + wc * 32 + 8 * fq;
        const float* bf = u.pm < 32 ? b0 : b1 - (size_t)8192 * 1024;
        f32x4 gv[2][2], gm[2][2];
#pragma unroll
        for (int bj = 0; bj < 2; ++bj)
#pragma unroll
            for (int n = 0; n < 2; ++n) { const int c = col0 + bj * HALF + 4 * n; gv[bj][n] = *(const f32x4*)(gate + cb * 6144 + c);
                if (NORM) gm[bj][n] = *(const f32x4*)(gn + c) * (*(const f32x4*)(sc + cb * 6144 + c) + 1.0f); }
#pragma unroll
        for (int ai = 0; ai < 2; ++ai)
#pragma unroll
            for (int m = 0; m < 4; ++m) { const int row = row0 + ai * HALF + m * 16; float ss = 0.f;
#pragma unroll
                for (int bj = 0; bj < 2; ++bj) { const size_t off = (size_t)row * 1024 + col0 + bj * HALF; f32x4 x0, x1;
                    if (F32BASE) { x0 = *(const f32x4*)(bf + off); x1 = *(const f32x4*)(bf + off + 4); }
                    else { const u32x4 w = *(const u32x4*)(XI + off); x0 = (f32x4){__uint_as_float(w.x << 16), __uint_as_float(w.x & 0xffff0000u), __uint_as_float(w.y << 16), __uint_as_float(w.y & 0xffff0000u)};
                        x1 = (f32x4){__uint_as_float(w.z << 16), __uint_as_float(w.z & 0xffff0000u), __uint_as_float(w.w << 16), __uint_as_float(w.w & 0xffff0000u)}; }
                    x0 = x0 + gv[bj][0] * acc[ai][bj][m][0]; x1 = x1 + gv[bj][1] * acc[ai][bj][m][1];
                    u32x4 o; o.x = cvt_pk_bf16(x0[0], x0[1]); o.y = cvt_pk_bf16(x0[2], x0[3]); o.z = cvt_pk_bf16(x1[0], x1[1]); o.w = cvt_pk_bf16(x1[2], x1[3]);
                    *(u32x4*)(XO + off) = o;
                    if (NORM) { ss += ((x0[0] * x0[0] + x0[1] * x0[1]) + (x0[2] * x0[2] + x0[3] * x0[3])) + ((x1[0] * x1[0] + x1[1] * x1[1]) + (x1[2] * x1[2] + x1[3] * x1[3]));
                        const f32x4 a0 = x0 * gm[bj][0], a1 = x1 * gm[bj][1];
                        u32x4 q; q.x = cvt_pk_bf16(a0[0], a0[1]); q.y = cvt_pk_bf16(a0[2], a0[3]); q.z = cvt_pk_bf16(a1[0], a1[1]); q.w = cvt_pk_bf16(a1[2], a1[3]);
                        *(u32x4*)(A + tiled_off(row, col0 + bj * HALF, 1024)) = q; } }
                if (NORM) { ss += __shfl_xor(ss, 16); ss += __shfl_xor(ss, 32); if (fq == 0) rsq[(size_t)row * 16 + u.pn * 4 + wc] = ss; } }
    }
};
template <class Epi, class Sched, bool ALIGN_EPI = false, bool SP2 = false>
__device__ __forceinline__ void gemm_phase(PG8_LAS unsigned char* lds, const Gemm g, const Sched& S, const Epi& E) {
    const int tid = threadIdx.x, wid = __builtin_amdgcn_readfirstlane(tid >> 6), lane = tid & 63, wr = wid >> 2, wc = wid & 3, fr = lane & 15, fq = lane >> 4;
    const int K = g.K, nt = K / BK;
    unsigned voffA[2], voffB[2];
#pragma unroll
    for (int i = 0; i < 2; ++i) { voffA[i] = (unsigned)(tid * 16 + i * 8192); voffB[i] = voffA[i]; }
    const size_t kstep = (size_t)(BM * BK * 2);
    const size_t hstep = (size_t)HALF * BK * 2;
    const size_t tstep = (size_t)BM * K * 2;
    const unsigned ldsw = (unsigned)wid * 1024u;
    const int aoff = lds_byte(wr * 64 + fr, fq * 8), boff = lds_byte(wc * 32 + fr, fq * 8);
#define PG8_SA(b, h) (((b) * 2 + (h)) * HTB)
#define PG8_SB(b, h) ((4 + (b) * 2 + (h)) * HTB)
#define PG8_STAGE(bufoff, gbase, voff) do { _Pragma("unroll") for (int _i = 0; _i < 2; ++_i) { \
        if ((bufoff) >= 4 * HTB) __builtin_amdgcn_global_load_lds((const unsigned*)((const char*)(gbase) + (voff)[_i]), (PG8_LAS unsigned*)(lds + (bufoff) + ldsw + _i * 8192), 16, 0, PG8_AUX_B); \
        else __builtin_amdgcn_global_load_lds((const unsigned*)((const char*)(gbase) + (voff)[_i]), (PG8_LAS unsigned*)(lds + (bufoff) + ldsw + _i * 8192), 16, 0, PG8_AUX_A); } } while (0)
#define PG8_LDA(dst, b, h) do { _Pragma("unroll") for (int m = 0; m < 4; ++m) _Pragma("unroll") for (int k = 0; k < 2; ++k) dst[m][k] = *(const PG8_LAS bf16x8*)(lds + PG8_SA(b, h) + aoff + m * 2048 + k * 1024); } while (0)
#define PG8_LDB(dst, b, h) do { _Pragma("unroll") for (int n = 0; n < 2; ++n) _Pragma("unroll") for (int k = 0; k < 2; ++k) dst[n][k] = *(const PG8_LAS bf16x8*)(lds + PG8_SB(b, h) + boff + n * 2048 + k * 1024); } while (0)
#define PG8_MMA(ai, bj, At, Bt) do { __builtin_amdgcn_s_setprio(1); _Pragma("unroll") for (int m = 0; m < 4; ++m) _Pragma("unroll") for (int n = 0; n < 2; ++n) _Pragma("unroll") for (int k = 0; k < 2; ++k) \
        acc[ai][bj][m][n] = __builtin_amdgcn_mfma_f32_16x16x32_bf16(Bt[n][k], At[m][k], acc[ai][bj][m][n], 0, 0, 0); __builtin_amdgcn_s_setprio(0); } while (0)
#define PG8_WAIT_V(n) asm volatile("s_waitcnt vmcnt(" #n ")" ::: "memory")
#define PG8_WAIT_L(n) asm volatile("s_waitcnt lgkmcnt(" #n ")" ::: "memory")
#define PG8_BAR __builtin_amdgcn_s_barrier()
#define PG8_SCHED __builtin_amdgcn_sched_barrier(0)
    Unit cur, nxt; int ui = 0;
    if (!S.next(0, cur)) return;
    f32x4 acc[2][2][4][2];
#pragma unroll
    for (int a = 0; a < 2; ++a)
#pragma unroll
        for (int b = 0; b < 2; ++b)
#pragma unroll
            for (int m = 0; m < 4; ++m)
#pragma unroll
                for (int n = 0; n < 2; ++n) acc[a][b][m][n] = (f32x4){0.f, 0.f, 0.f, 0.f};
    bf16x8 At[4][2], B0[2][2], B1[2][2];
    const char* cA = (const char*)g.A + (size_t)cur.pm * tstep; const char* cB = (const char*)g.Bt + (size_t)cur.pn * tstep;
    S.a_ready(cur);
    if constexpr (SP2) {
        PG8_STAGE(PG8_SB(0, 0), cB, voffB); PG8_STAGE(PG8_SB(0, 1), cB + hstep, voffB); PG8_STAGE(PG8_SA(0, 0), cA, voffA); PG8_STAGE(PG8_SA(0, 1), cA + hstep, voffA);
        if (wr == 1) PG8_BAR;
        PG8_WAIT_V(2); PG8_BAR;
        PG8_STAGE(PG8_SB(1, 0), cB + kstep, voffB); PG8_STAGE(PG8_SA(1, 0), cA + kstep, voffA); PG8_STAGE(PG8_SB(1, 1), cB + hstep + kstep, voffB);
        PG8_WAIT_V(6); PG8_BAR;
    } else {
        PG8_STAGE(PG8_SB(0, 0), cB, voffB); PG8_STAGE(PG8_SA(0, 0), cA, voffA); PG8_STAGE(PG8_SB(0, 1), cB + hstep, voffB); PG8_STAGE(PG8_SA(0, 1), cA + hstep, voffA);
        if (wr == 1) PG8_BAR;
        PG8_WAIT_V(4); PG8_BAR;
        PG8_STAGE(PG8_SB(1, 0), cB + kstep, voffB); PG8_STAGE(PG8_SA(1, 0), cA + kstep, voffA); PG8_STAGE(PG8_SB(1, 1), cB + hstep + kstep, voffB);
        PG8_WAIT_V(6); PG8_BAR;
    }
    for (;;) {
        const bool has_next = S.next(ui + 1, nxt);
        const char* nA = has_next ? (const char*)g.A + (size_t)nxt.pm * tstep : cA; const char* nB = has_next ? (const char*)g.Bt + (size_t)nxt.pn * tstep : cB;
        for (int t = 0; t < nt; t += 2) {
            const bool last = (t == nt - 2);
            const char* a1 = cA + (size_t)(t + 1) * kstep;
            const char* a2 = last ? nA : cA + (size_t)(t + 2) * kstep; const char* b2 = last ? nB : cB + (size_t)(t + 2) * kstep;
            const char* a3 = a2 + kstep; const char* b3 = b2 + kstep;
            if (last && has_next) S.a_ready(nxt);
            if constexpr (SP2) {
            PG8_LDB(B0, 0, 0); PG8_LDB(B1, 0, 1); PG8_SCHED; PG8_LDA(At, 0, 0); PG8_STAGE(PG8_SA(1, 1), a1 + hstep, voffA);
            PG8_WAIT_V(8); PG8_WAIT_L(0); PG8_BAR; PG8_MMA(0, 0, At, B0); PG8_MMA(0, 1, At, B1); PG8_BAR; PG8_SCHED;
            PG8_LDA(At, 0, 1); PG8_STAGE(PG8_SB(0, 0), b2, voffB); PG8_STAGE(PG8_SB(0, 1), b2 + hstep, voffB); PG8_STAGE(PG8_SA(0, 0), a2, voffA);
            PG8_WAIT_V(8); PG8_WAIT_L(0); PG8_BAR; PG8_MMA(1, 0, At, B0); PG8_MMA(1, 1, At, B1); PG8_BAR; PG8_SCHED;
            PG8_LDB(B0, 1, 0); PG8_LDB(B1, 1, 1); PG8_SCHED; PG8_LDA(At, 1, 0); PG8_STAGE(PG8_SA(0, 1), a2 + hstep, voffA);
            PG8_WAIT_V(8); PG8_WAIT_L(0); PG8_BAR; PG8_MMA(0, 0, At, B0); PG8_MMA(0, 1, At, B1); PG8_BAR; PG8_SCHED;
            PG8_LDA(At, 1, 1); PG8_STAGE(PG8_SB(1, 0), b3, voffB); PG8_STAGE(PG8_SB(1, 1), b3 + hstep, voffB); PG8_STAGE(PG8_SA(1, 0), a3, voffA);
            PG8_WAIT_V(8); PG8_WAIT_L(0); PG8_BAR; PG8_MMA(1, 0, At, B0); PG8_MMA(1, 1, At, B1); PG8_BAR; PG8_SCHED;
            } else {
            PG8_LDB(B0, 0, 0); PG8_SCHED; PG8_LDA(At, 0, 0); PG8_STAGE(PG8_SA(1, 1), a1 + hstep, voffA);
            PG8_WAIT_L(8); PG8_BAR; PG8_WAIT_L(0); PG8_MMA(0, 0, At, B0); PG8_BAR; PG8_SCHED;
            PG8_LDB(B1, 0, 1); PG8_STAGE(PG8_SB(0, 0), b2, voffB);
            PG8_BAR; PG8_WAIT_L(0); PG8_MMA(0, 1, At, B1); PG8_BAR;
            PG8_LDA(At, 0, 1); PG8_STAGE(PG8_SA(0, 0), a2, voffA);
            PG8_BAR; PG8_WAIT_L(0); PG8_MMA(1, 0, At, B0); PG8_BAR; PG8_SCHED;
            PG8_STAGE(PG8_SB(0, 1), b2 + hstep, voffB);
            PG8_WAIT_V(6); PG8_BAR; PG8_MMA(1, 1, At, B1); PG8_BAR;
            PG8_LDB(B0, 1, 0); PG8_SCHED; PG8_LDA(At, 1, 0); PG8_STAGE(PG8_SA(0, 1), a2 + hstep, voffA);
            PG8_WAIT_L(8); PG8_BAR; PG8_WAIT_L(0); PG8_MMA(0, 0, At, B0); PG8_BAR; PG8_SCHED;
            PG8_LDB(B1, 1, 1); PG8_STAGE(PG8_SB(1, 0), b3, voffB);
            PG8_BAR; PG8_WAIT_L(0); PG8_MMA(0, 1, At, B1); PG8_BAR;
            PG8_LDA(At, 1, 1); PG8_STAGE(PG8_SA(1, 0), a3, voffA);
            PG8_BAR; PG8_WAIT_L(0); PG8_MMA(1, 0, At, B0); PG8_BAR; PG8_SCHED;
            PG8_STAGE(PG8_SB(1, 1), b3 + hstep, voffB);
            PG8_WAIT_V(6); PG8_BAR; PG8_MMA(1, 1, At, B1); PG8_BAR;
            }
        }
        if constexpr (ALIGN_EPI) { if (wr == 0) PG8_BAR; }
        if constexpr (!Epi::AFTER_DRAIN) { E(acc, cur, wr, wc, fr, fq); S.done(cur); }
        if (!has_next) break;
#pragma unroll
        for (int a = 0; a < 2; ++a)
#pragma unroll
            for (int b = 0; b < 2; ++b)
#pragma unroll
                for (int m = 0; m < 4; ++m)
#pragma unroll
                    for (int n = 0; n < 2; ++n) acc[a][b][m][n] = (f32x4){0.f, 0.f, 0.f, 0.f};
        cur = nxt; cA = nA; cB = nB; ++ui;
        if constexpr (ALIGN_EPI) { if (wr == 1) PG8_BAR; }
    }
    PG8_WAIT_V(0);
    if constexpr (!ALIGN_EPI) { if (wr == 0) PG8_BAR; }
    PG8_BAR;
    if constexpr (Epi::AFTER_DRAIN) { E.fused(acc, cur, wr, wc, fr, fq, lds, wid, lane); S.done(cur); }
#undef PG8_SA
#undef PG8_SB
#undef PG8_STAGE
#undef PG8_LDA
#undef PG8_LDB
#undef PG8_MMA
#undef PG8_WAIT_V
#undef PG8_WAIT_L
#undef PG8_BAR
#undef PG8_SCHED
}
}
constexpr int D = 1024, MCTX = 8192, MLAT = 32768, M = MCTX + MLAT;
constexpr int NAB = 3584, FF = 2816, NGU = 2 * FF, NC = 2048, NCOND = 9, MODW = 6 * D;
constexpr float EPS = 1e-6f;
constexpr int NWAVES = 8, NTHREADS = 512;
#ifndef ONE_LAUNCH
#define ONE_LAUNCH 1
#endif
constexpr int N_PHASES = 18;
#ifndef PH_MASK
#define PH_MASK 0x3ffff
#endif
#ifndef STAG_TICKS
#define STAG_TICKS 0
#endif
#ifndef ONE_LAUNCH
#define ONE_LAUNCH 1
#endif
constexpr size_t MiB = 1u << 20;
constexpr size_t WS_MOD = 0;
constexpr size_t WS_ROPE = 1 * MiB;
constexpr size_t WS_VSQ = 2 * MiB;
constexpr size_t WS_SHW = 512 * 1024;
constexpr size_t WS_RSQ = 4 * MiB + 512 * 1024;
constexpr size_t WS_BAR = 7 * MiB + 512 * 1024;
constexpr size_t WS_WAB = 8 * MiB;
constexpr size_t WS_WOAB = 15 * MiB;
constexpr size_t WS_WINC = 17 * MiB;
constexpr size_t WS_WOC = 21 * MiB;
constexpr size_t WS_WGU = 23 * MiB;
constexpr size_t WS_WDN = 45 * MiB;
constexpr size_t WS_HB = 56 * MiB;
constexpr size_t WS_YB = 136 * MiB;
constexpr size_t WS_P = 216 * MiB;
constexpr size_t WS_END = 496 * MiB;
constexpr int LDS_BYTES = 147456;
constexpr int MISC_OFF = LDS_BYTES - 64;
constexpr int TS = 136, TILE_B = 128 * TS * 2;
constexpr int VS = 264;

#define LAS __attribute__((address_space(3)))
typedef unsigned short bf16;
typedef unsigned v4u __attribute__((ext_vector_type(4)));
typedef unsigned v2u __attribute__((ext_vector_type(2)));
typedef float f32x4 __attribute__((ext_vector_type(4)));
typedef short bf16x8 __attribute__((ext_vector_type(8)));
typedef short s16x4 __attribute__((ext_vector_type(4)));
typedef LAS unsigned char* ldsp;

__device__ __forceinline__ float bflo(unsigned w) { return __uint_as_float(w << 16); }
__device__ __forceinline__ float bfhi(unsigned w) { return __uint_as_float(w & 0xffff0000u); }
__device__ __forceinline__ unsigned pk2(float lo, float hi) { return pg8::cvt_pk_bf16(lo, hi); }
__device__ __forceinline__ s16x4 vtr(const LAS unsigned char* p) { return __builtin_bit_cast(s16x4, __builtin_amdgcn_ds_read_tr16_b64_v4i16((LAS s16x4*)p)); }
__device__ __forceinline__ bf16x8 tr_frag(const LAS unsigned char* p, int off2) { const s16x4 a = vtr(p), b = vtr(p + off2); return __builtin_shufflevector(a, b, 0, 1, 2, 3, 4, 5, 6, 7); }
__device__ __forceinline__ f32x4 mfma16(bf16x8 a, bf16x8 b, f32x4 c) { return __builtin_amdgcn_mfma_f32_16x16x32_bf16(a, b, c, 0, 0, 0); }
__device__ __forceinline__ float wave_sum(float v) {
#pragma unroll
    for (int o = 1; o < 64; o <<= 1) v += __shfl_xor(v, o);
    return v;
}
__device__ __forceinline__ float log2_sigmoid(float x) { return -log1pf(expf(-x)) * 1.4426950408889634f; }

struct Args {
    const float* in[24]; float* out; unsigned char* ws; int ph_lo, ph_hi;
};

__device__ __forceinline__ void transpose_item(const float* W, int K, int N, bf16* WT, int k0, int n0, int dst_row0, float scale, LAS float* scr, int lane) {
    float wv[32];
#pragma unroll
    for (int i = 0; i < 32; ++i) wv[i] = W[(size_t)(k0 + 2 * i + (lane >> 5)) * N + n0 + (lane & 31)];
#pragma unroll
    for (int i = 0; i < 32; ++i) scr[(2 * i + (lane >> 5)) * 33 + (lane & 31)] = wv[i];
    asm volatile("s_waitcnt lgkmcnt(0)" ::: "memory");
    const int c = lane & 7;
#pragma unroll
    for (int j = 0; j < 4; ++j) { const int n = (lane >> 3) + 8 * j; const LAS float* s = scr + (8 * c) * 33 + n;
        v4u o; o.x = pk2(s[0 * 33] * scale, s[1 * 33] * scale); o.y = pk2(s[2 * 33] * scale, s[3 * 33] * scale); o.z = pk2(s[4 * 33] * scale, s[5 * 33] * scale); o.w = pk2(s[6 * 33] * scale, s[7 * 33] * scale);
        *(v4u*)(WT + pg8::tiled_off_b(dst_row0 + n, k0 + 8 * c, K)) = o; }
    asm volatile("s_waitcnt lgkmcnt(0)" ::: "memory");
}

constexpr int CONV_EARLY = 5120, CONV_ALL = 12288;
__device__ __forceinline__ void convert_range(const Args& a, ldsp lds, int it_lo, int it_hi, int gw, int NGW, int lane, int wave) {
    unsigned char* ws = a.ws; LAS float* scr = (LAS float*)lds + wave * (64 * 33);
    for (int it = it_lo + gw; it < it_hi; it += NGW) {
        int r = it; const float* W; int K, N; bf16* WT; int mode = 0;
        if (r < 1792) { W = a.in[9]; K = 1024; N = NAB; WT = (bf16*)(ws + WS_WAB); mode = 3; }
        else if ((r -= 1792) < 512) { W = a.in[14]; K = 1024; N = 1024; WT = (bf16*)(ws + WS_WOAB); }
        else if ((r -= 512) < 1408) { W = a.in[20]; K = 1024; N = FF; WT = (bf16*)(ws + WS_WGU); mode = 1; }
        else if ((r -= 1408) < 1408) { W = a.in[21]; K = 1024; N = FF; WT = (bf16*)(ws + WS_WGU); mode = 2; }
        else if ((r -= 1408) < 1408) { W = a.in[22]; K = FF; N = 1024; WT = (bf16*)(ws + WS_WDN); }
        else if ((r -= 1408) < 1024) { W = a.in[15]; K = 1024; N = NC; WT = (bf16*)(ws + WS_WINC); }
        else if ((r -= 1024) < 512) { W = a.in[19]; K = 1024; N = 1024; WT = (bf16*)(ws + WS_WOC); }
        else if ((r -= 512) < 1408) { W = a.in[20] + (size_t)1024 * FF; K = 1024; N = FF; WT = (bf16*)(ws + WS_WGU) + (size_t)NGU * 1024; mode = 1; }
        else if ((r -= 1408) < 1408) { W = a.in[21] + (size_t)1024 * FF; K = 1024; N = FF; WT = (bf16*)(ws + WS_WGU) + (size_t)NGU * 1024; mode = 2; }
        else { r -= 1408; W = a.in[22] + (size_t)FF * 1024; K = FF; N = 1024; WT = (bf16*)(ws + WS_WDN) + (size_t)1024 * FF; }
        const int nblk = N / 32, kb = r / nblk, nb = r % nblk, k0 = 64 * kb, n0 = 32 * nb;
        int drow = n0; float scale = 1.0f;
        if (mode == 1) drow = (n0 >> 7) * 256 + (n0 & 127);
        else if (mode == 2) drow = (n0 >> 7) * 256 + 128 + (n0 & 127);
        else if (mode == 3 && n0 < 512) scale = 0.08838834764831845f;
        transpose_item(W, K, N, WT, k0, n0, drow, scale, scr, lane);
    }
}

__device__ __forceinline__ void p0_prologue(const Args& a, ldsp lds, int tid, int lane, int wave) {
    unsigned char* ws = a.ws;
    LAS float* L = (LAS float*)lds;
    const int bx = blockIdx.x, G = gridDim.x;
    for (int job = bx; job < 192; job += G) {
        const float* c = a.in[3]; const float* c_ctx = a.in[4]; const float* ada_w = a.in[5]; const float* ada_b = a.in[6];
        float* mod = (float*)(ws + WS_MOD);
        for (int e = tid; e < NCOND * 1024; e += NTHREADS) { const int b = e >> 10, k = e & 1023; const float cv = (b == 0) ? c_ctx[k] : c[(b - 1) * 1024 + k]; L[e] = cv / (1.0f + __expf(-cv)); }
        __syncthreads();
        const int l = job / 96, n0 = (job % 96) * 64;
        const float* W = ada_w + ((size_t)l * 1024 + 128 * wave) * MODW + n0 + lane;
        float acc[NCOND];
#pragma unroll
        for (int b = 0; b < NCOND; ++b) acc[b] = 0.f;
        for (int kk = 0; kk < 128; kk += 32) {
            float w[32];
#pragma unroll
            for (int u = 0; u < 32; ++u) w[u] = W[(size_t)(kk + u) * MODW];
#pragma unroll
            for (int u = 0; u < 32; ++u)
#pragma unroll
                for (int b = 0; b < NCOND; ++b) acc[b] += L[b * 1024 + 128 * wave + kk + u] * w[u];
        }
        LAS float* red = L + NCOND * 1024;
#pragma unroll
        for (int b = 0; b < NCOND; ++b) red[(wave * NCOND + b) * 64 + lane] = acc[b];
        __syncthreads();
        for (int e = tid; e < NCOND * 64; e += NTHREADS) { const int b = e >> 6, ln = e & 63; float s = ada_b[l * MODW + n0 + ln];
#pragma unroll
            for (int w = 0; w < 8; ++w) s += red[(w * NCOND + b) * 64 + ln];
            mod[(size_t)(l * NCOND + b) * MODW + n0 + ln] = s; }
        __syncthreads();
    }
    if (bx == G - 1) {
        float* tab = (float*)(ws + WS_ROPE);
        for (int e = tid; e < 2048; e += NTHREADS) { const int pos = e >> 5, f = e & 31; const float fr = exp2f(-(float)f * (13.287712379549449f / 32.0f)); const float ang = (float)pos * fr;
            float rev = ang * 0.15915494309189535f; rev -= floorf(rev); tab[e] = __builtin_amdgcn_cosf(rev); tab[2048 + e] = __builtin_amdgcn_sinf(rev); }
    }
    convert_range(a, lds, 0, G == 256 ? CONV_EARLY : CONV_ALL, bx * NWAVES + wave, G * NWAVES, lane, wave);
}

template <bool FIRST>
__device__ __forceinline__ void norm_pass(const Args& a, const float* gn, const float* modl, int off_sh, int off_sc, bf16* outp, int lane, int wave) {
    const int gw = blockIdx.x * NWAVES + wave, NGW = gridDim.x * NWAVES;
    for (int m0 = gw; m0 < M; m0 += 2 * NGW) {
        const int m1 = m0 + NGW; const bool two = m1 < M;
        f32x4 v[2][4]; float s[2] = {0.f, 0.f};
#pragma unroll
        for (int q = 0; q < 2; ++q) { const int m = (q == 0 || two) ? (q == 0 ? m0 : m1) : m0;
            const float* xrow = FIRST ? (m < MCTX ? a.in[0] + (size_t)m * D : a.in[1] + (size_t)(m - MCTX) * D) : a.out + (size_t)m * D;
            const f32x4* xr = (const f32x4*)xrow + lane;
#pragma unroll
            for (int j = 0; j < 4; ++j) v[q][j] = xr[64 * j]; }
#pragma unroll
        for (int q = 0; q < 2; ++q) {
#pragma unroll
            for (int j = 0; j < 4; ++j) s[q] += (v[q][j].x * v[q][j].x + v[q][j].y * v[q][j].y) + (v[q][j].z * v[q][j].z + v[q][j].w * v[q][j].w); }
#pragma unroll
        for (int q = 0; q < 2; ++q) { if (q == 1 && !two) break; const int m = q == 0 ? m0 : m1;
            const int cb = m < MCTX ? 0 : 1 + ((m - MCTX) >> 12);
            const float rstd = rsqrtf(wave_sum(s[q]) * (1.0f / D) + EPS);
            const float* mrow = modl + (size_t)cb * MODW;
#pragma unroll
            for (int j = 0; j < 4; ++j) { const int col = 4 * lane + 256 * j;
                const f32x4 g4 = *(const f32x4*)(gn + col), sc4 = *(const f32x4*)(mrow + off_sc + col), sh4 = *(const f32x4*)(mrow + off_sh + col);
                const f32x4 o = v[q][j] * rstd * g4 * (sc4 + 1.0f) + sh4;
                v2u w; w.x = pk2(o.x, o.y); w.y = pk2(o.z, o.w); *(v2u*)(outp + pg8::tiled_off(m, col, D)) = w; } }
    }
}
__device__ __forceinline__ void final_norm(const Args& a, const float* gn, int lane, int wave) {
    const int gw = blockIdx.x * NWAVES + wave, NGW = gridDim.x * NWAVES;
    for (int m = gw; m < M; m += NGW) {
        f32x4* xr = (f32x4*)(a.out + (size_t)m * D) + lane;
        f32x4 v[4]; float s = 0.f;
#pragma unroll
        for (int j = 0; j < 4; ++j) { v[j] = xr[64 * j]; s += (v[j].x * v[j].x + v[j].y * v[j].y) + (v[j].z * v[j].z + v[j].w * v[j].w); }
        const float rstd = rsqrtf(wave_sum(s) * (1.0f / D) + EPS);
#pragma unroll
        for (int j = 0; j < 4; ++j) { const f32x4 g4 = *(const f32x4*)(gn + 4 * lane + 256 * j); xr[64 * j] = v[j] * rstd * g4; }
    }
}

__device__ __forceinline__ void ld_tile(const bf16* src, int tid, v4u (&x)[2][2]) {
#pragma unroll
    for (int rep = 0; rep < 2; ++rep) { const int it = tid + rep * NTHREADS, tok = it >> 3, d0 = (it & 7) * 8;
        x[rep][0] = *(const v4u*)(src + (size_t)tok * NAB + d0); x[rep][1] = *(const v4u*)(src + (size_t)tok * NAB + 64 + d0); }
}
__device__ __forceinline__ void st_rope_tile(ldsp T, const v4u (&x)[2][2], bool rope, int tpos0, const float* tab, int tid) {
#pragma unroll
    for (int rep = 0; rep < 2; ++rep) { const int it = tid + rep * NTHREADS, tok = it >> 3, d0 = (it & 7) * 8;
        v4u x1 = x[rep][0], x2 = x[rep][1];
        if (rope) { const int tpos = tpos0 + tok, pos = d0 < 32 ? (tpos >> 6) : (tpos & 63), f0 = d0 & 31;
            const f32x4 c0 = *(const f32x4*)(tab + pos * 32 + f0), c1 = *(const f32x4*)(tab + pos * 32 + f0 + 4), s0 = *(const f32x4*)(tab + 2048 + pos * 32 + f0), s1 = *(const f32x4*)(tab + 2048 + pos * 32 + f0 + 4);
            const float cs[8] = {c0.x, c0.y, c0.z, c0.w, c1.x, c1.y, c1.z, c1.w}, sn[8] = {s0.x, s0.y, s0.z, s0.w, s1.x, s1.y, s1.z, s1.w};
            v4u o1, o2;
#pragma unroll
            for (int w = 0; w < 4; ++w) { const float a0 = bflo(x1[w]), a1 = bfhi(x1[w]), b0 = bflo(x2[w]), b1 = bfhi(x2[w]);
                o1[w] = pk2(a0 * cs[2 * w] - b0 * sn[2 * w], a1 * cs[2 * w + 1] - b1 * sn[2 * w + 1]);
                o2[w] = pk2(b0 * cs[2 * w] + a0 * sn[2 * w], b1 * cs[2 * w + 1] + a1 * sn[2 * w + 1]); }
            x1 = o1; x2 = o2; }
        *(LAS v4u*)(T + (tok * TS + d0) * 2) = x1; *(LAS v4u*)(T + (tok * TS + 64 + d0) * 2) = x2; }
}
__device__ __forceinline__ void ld_vtile(const bf16* src, int tid, v4u (&x)[4]) {
#pragma unroll
    for (int rep = 0; rep < 4; ++rep) { const int it = tid + rep * NTHREADS, tok = it >> 4, ch = it & 15; x[rep] = *(const v4u*)(src + (size_t)tok * NAB + ch * 8); }
}

__device__ __forceinline__ void r1_phase(const Args& a, ldsp lds, int tid0, int lane, int wave) {
    const bf16* P = (const bf16*)(a.ws + WS_P); bf16* UB = (bf16*)(a.ws + WS_YB); const float* tab = (const float*)(a.ws + WS_ROPE);
    const ldsp Kt = lds, Vf = lds + TILE_B, Vb = lds + 2 * TILE_B;
    const int r0 = lane & 15, kq0 = lane >> 4;
    v4u pk_[2][2], pv_[4];
    if ((int)blockIdx.x < 1280) { const int u = blockIdx.x; const bf16* Pg = P + (size_t)(u >> 2) * 128 * NAB; ld_tile(Pg + 512 + (u & 3) * 128, tid0, pk_); ld_vtile(Pg + 1024 + (u & 3) * 128, tid0, pv_); }
    for (int u = blockIdx.x; u < 1280; u += gridDim.x) {
        const int cidx = u >> 2, h = u & 3, row0 = cidx * 128; const bool lat = cidx >= 64; const int tpos0 = lat ? ((cidx - 64) & 31) * 128 : 0;
        const float l2f = log2_sigmoid(a.in[10][h]), l2b = log2_sigmoid(a.in[10][4 + h]);
        int tid = tid0, r = r0, kq = kq0; asm volatile("" : "+v"(tid), "+v"(r), "+v"(kq));
        __syncthreads();
        st_rope_tile(Kt, pk_, lat, tpos0, tab, tid);
#pragma unroll
        for (int rep = 0; rep < 4; ++rep) { const int it = tid + rep * NTHREADS, tok = it >> 4, ch = it & 15;
            const v4u x = pv_[rep];
            const float sf = __builtin_amdgcn_exp2f((float)(127 - tok) * l2f), sb = __builtin_amdgcn_exp2f((float)tok * l2b);
            v4u of, ob;
#pragma unroll
            for (int w = 0; w < 4; ++w) { const float lo = bflo(x[w]), hi = bfhi(x[w]); of[w] = pk2(lo * sf, hi * sf); ob[w] = pk2(lo * sb, hi * sb); }
            *(LAS v4u*)(Vf + (tok * TS + ch * 8) * 2) = of; *(LAS v4u*)(Vb + (tok * TS + ch * 8) * 2) = ob; }
        __syncthreads();
        { const int un = u + gridDim.x; if (un < 1280) { const bf16* Pn = P + (size_t)(un >> 2) * 128 * NAB; ld_tile(Pn + 512 + (un & 3) * 128, tid, pk_); ld_vtile(Pn + 1024 + (un & 3) * 128, tid, pv_); } }
        f32x4 acc[2][8];
#pragma unroll
        for (int d = 0; d < 2; ++d)
#pragma unroll
            for (int mt = 0; mt < 8; ++mt) acc[d][mt] = (f32x4){0.f, 0.f, 0.f, 0.f};
#pragma unroll
        for (int ks = 0; ks < 4; ++ks) { const int j0 = ks * 32 + kq * 8 + (r >> 2);
            const bf16x8 vfa = tr_frag(Vf + (j0 * TS + 16 * wave + 4 * (r & 3)) * 2, 8 * TS), vba = tr_frag(Vb + (j0 * TS + 16 * wave + 4 * (r & 3)) * 2, 8 * TS);
#pragma unroll
            for (int mt = 0; mt < 8; ++mt) { const bf16x8 ka = tr_frag(Kt + (j0 * TS + mt * 16 + 4 * (r & 3)) * 2, 8 * TS);
                acc[0][mt] = mfma16(ka, vfa, acc[0][mt]); acc[1][mt] = mfma16(ka, vba, acc[1][mt]); } }
#pragma unroll
        for (int d = 0; d < 2; ++d)
#pragma unroll
            for (int mt = 0; mt < 8; ++mt) { v2u w; w.x = pk2(acc[d][mt][0], acc[d][mt][1]); w.y = pk2(acc[d][mt][2], acc[d][mt][3]);
                *(v2u*)(UB + ((size_t)(u * 2 + d) * 128 + 16 * wave + r) * 128 + mt * 16 + 4 * kq) = w; }
    }
}

constexpr int SCAN_B = 8;
__device__ __forceinline__ void scan_item(const bf16* UB, bf16* SB, int cidx0, int n, int h, int dir, int e8, float dec, const float* S0, float* Sout) {
    const int dv = e8 >> 4, dk0 = (e8 & 15) * 8;
    float S[8];
#pragma unroll
    for (int i = 0; i < 8; ++i) S[i] = S0 ? S0[(size_t)(dk0 + i) * 128 + dv] : 0.f;
    for (int s0 = 0; s0 < n; s0 += SCAN_B) {
        v4u uu[SCAN_B]; size_t off[SCAN_B];
#pragma unroll
        for (int j = 0; j < SCAN_B; ++j) { const int st = s0 + j, c = dir == 0 ? st : n - 1 - st; off[j] = ((size_t)((cidx0 + c) * 4 + h) * 2 + dir) * 16384 + (size_t)e8 * 8;
            if (st < n) uu[j] = *(const v4u*)(UB + off[j]); else uu[j] = (v4u){0u, 0u, 0u, 0u}; }
#pragma unroll
        for (int j = 0; j < SCAN_B; ++j) { if (s0 + j < n) {
            v4u so; so.x = pk2(S[0], S[1]); so.y = pk2(S[2], S[3]); so.z = pk2(S[4], S[5]); so.w = pk2(S[6], S[7]);
            *(v4u*)(SB + off[j]) = so;
#pragma unroll
            for (int w = 0; w < 4; ++w) { S[2 * w] = dec * S[2 * w] + bflo(uu[j][w]); S[2 * w + 1] = dec * S[2 * w + 1] + bfhi(uu[j][w]); } } }
    }
    if (Sout) {
#pragma unroll
        for (int i = 0; i < 8; ++i) Sout[(size_t)(dk0 + i) * 128 + dv] = S[i]; }
}
__device__ __forceinline__ void r2_phase(const Args& a, int tid) {
    const bf16* UB = (const bf16*)(a.ws + WS_YB); bf16* SB = (bf16*)(a.ws + WS_HB);
    const int NT = gridDim.x * NTHREADS;
    for (int t = blockIdx.x * NTHREADS + tid; t < 131072; t += NT) {
        const int e8 = t & 2047, dir = (t >> 11) & 1, h = (t >> 12) & 3, s = t >> 14;
        const float dec = exp2f(128.0f * log2_sigmoid(a.in[10][dir * 4 + h]));
        scan_item(UB, SB, 64 + s * 32, 32, h, dir, e8, dec, a.in[2] + (size_t)((s * 2 + dir) * 4 + h) * 16384, nullptr);
    }
    for (int t = blockIdx.x * NTHREADS + tid; t < 524288; t += NT) {
        const int e8 = t & 2047, dir = (t >> 11) & 1, h = (t >> 12) & 3, s = t >> 14;
        const float dec = exp2f(128.0f * log2_sigmoid(a.in[10][dir * 4 + h]));
        scan_item(UB, SB, s * 2, 2, h, dir, e8, dec, nullptr, a.out + (size_t)M * D + (size_t)((s * 2 + dir) * 4 + h) * 16384);
    }
}

__device__ __forceinline__ void r3_phase(const Args& a, ldsp lds, int tid0, int lane, int wave) {
    const bf16* P = (const bf16*)(a.ws + WS_P); const bf16* SB = (const bf16*)(a.ws + WS_HB); bf16* YB = (bf16*)(a.ws + WS_YB); const float* tab = (const float*)(a.ws + WS_ROPE);
    const ldsp Qt = lds, Kt = lds + TILE_B, Vt = lds + 2 * TILE_B, Pt = lds + 3 * TILE_B;
    const int r0 = lane & 15, kq0 = lane >> 4;
#ifndef NO_RET
    v4u pq_[2][2], pk_[2][2], pv_[4];
    v4u pg_[4];
    if ((int)blockIdx.x < 1280) { const int u = blockIdx.x, ln = tid0 & 63; const bf16* gp = P + (size_t)((u >> 2) * 128 + 16 * wave + (ln >> 2)) * NAB + 1536 + (u & 3) * 128 + (ln & 3) * 32;
#pragma unroll
        for (int k = 0; k < 4; ++k) pg_[k] = *(const v4u*)(gp + k * 8); }
    if ((int)blockIdx.x < 1280) { const int u = blockIdx.x; const bf16* Pg0 = P + (size_t)(u >> 2) * 128 * NAB; ld_tile(Pg0 + (u & 3) * 128, tid0, pq_); ld_tile(Pg0 + 512 + (u & 3) * 128, tid0, pk_); ld_vtile(Pg0 + 1024 + (u & 3) * 128, tid0, pv_); }
    for (int u = blockIdx.x; u < 1280; u += gridDim.x) {
        const int cidx = u >> 2, h = u & 3, row0 = cidx * 128; const bool lat = cidx >= 64; const int tpos0 = lat ? ((cidx - 64) & 31) * 128 : 0;
        const float l2f = log2_sigmoid(a.in[10][h]), l2b = log2_sigmoid(a.in[10][4 + h]);
        const bf16* Pg = P + (size_t)row0 * NAB;
        int tid = tid0, r = r0, kq = kq0; asm volatile("" : "+v"(tid), "+v"(r), "+v"(kq));
        __syncthreads();
        st_rope_tile(Qt, pq_, lat, tpos0, tab, tid);
        st_rope_tile(Kt, pk_, lat, tpos0, tab, tid);
#pragma unroll
        for (int rep = 0; rep < 4; ++rep) { const int it = tid + rep * NTHREADS, tok = it >> 4, ch = it & 15; *(LAS v4u*)(Vt + (tok * TS + ch * 8) * 2) = pv_[rep]; }
        __syncthreads();
        { const int un = u + gridDim.x; if (un < 1280) { const bf16* Pn = P + (size_t)(un >> 2) * 128 * NAB; ld_tile(Pn + (un & 3) * 128, tid, pq_); ld_tile(Pn + 512 + (un & 3) * 128, tid, pk_); ld_vtile(Pn + 1024 + (un & 3) * 128, tid, pv_); } }
        const int il = 16 * wave + r;
        int ilq = il - 4 * kq; asm volatile("" : "+v"(ilq));
        bf16x8 qf[4];
#pragma unroll
        for (int ks = 0; ks < 4; ++ks) qf[ks] = *(const LAS bf16x8*)(Qt + (il * TS + ks * 32 + kq * 8) * 2);
#pragma unroll
        for (int nt = 0; nt < 8; ++nt) { f32x4 c = (f32x4){0.f, 0.f, 0.f, 0.f};
#pragma unroll
            for (int ks = 0; ks < 4; ++ks) { const bf16x8 kf = *(const LAS bf16x8*)(Kt + ((nt * 16 + r) * TS + ks * 32 + kq * 8) * 2); c = mfma16(kf, qf[ks], c); }
            float p[4];
#pragma unroll
            for (int e = 0; e < 4; ++e) { const float fd = (float)(ilq - (nt * 16 + e));
                const float dm = (fd == 0.0f) ? 2.0f : __builtin_amdgcn_exp2f(fmaxf(fd, 0.0f) * l2f + fmaxf(-fd, 0.0f) * l2b); p[e] = c[e] * dm; }
            v2u w; w.x = pk2(p[0], p[1]); w.y = pk2(p[2], p[3]);
            *(LAS v2u*)(Pt + (il * TS + nt * 16 + 4 * kq) * 2) = w; asm volatile("" ::: "memory"); }
        asm volatile("s_waitcnt lgkmcnt(0)" ::: "memory");
        __syncthreads();
        v4u sreg[4];
        { const bf16* Sg = SB + (size_t)(u * 2) * 16384;
#pragma unroll
          for (int rep = 0; rep < 4; ++rep) { const int it = tid + rep * NTHREADS; sreg[rep] = *(const v4u*)(Sg + (it >> 4) * 128 + (it & 15) * 8); } }
        f32x4 oi[8];
#pragma unroll
        for (int nt = 0; nt < 8; ++nt) oi[nt] = (f32x4){0.f, 0.f, 0.f, 0.f};
#pragma unroll
        for (int ks = 0; ks < 4; ++ks) { const bf16x8 pf = *(const LAS bf16x8*)(Pt + (il * TS + ks * 32 + kq * 8) * 2); const int j0 = ks * 32 + kq * 8 + (r >> 2);
#pragma unroll
            for (int nt = 0; nt < 8; ++nt) { const bf16x8 vf = tr_frag(Vt + (j0 * TS + nt * 16 + 4 * (r & 3)) * 2, 8 * TS); oi[nt] = mfma16(pf, vf, oi[nt]); }
            asm volatile("" ::: "memory"); }
#pragma unroll
        for (int rep = 0; rep < 4; ++rep) { const int it = tid + rep * NTHREADS; *(LAS v4u*)(Kt + ((it >> 4) * TS + (it & 15) * 8) * 2) = sreg[rep]; }
        __syncthreads();
        { const bf16* Sg = SB + (size_t)(u * 2 + 1) * 16384;
#pragma unroll
          for (int rep = 0; rep < 4; ++rep) { const int it = tid + rep * NTHREADS; sreg[rep] = *(const v4u*)(Sg + (it >> 4) * 128 + (it & 15) * 8); } }
        int iq = 16 * wave + 4 * kq; asm volatile("" : "+v"(iq));
#pragma unroll
        for (int dir = 0; dir < 2; ++dir) {
            const ldsp St = dir == 0 ? Kt : Vt;
            if (dir == 1) {
#pragma unroll
                for (int rep = 0; rep < 4; ++rep) { const int it = tid + rep * NTHREADS; *(LAS v4u*)(Vt + ((it >> 4) * TS + (it & 15) * 8) * 2) = sreg[rep]; }
                __syncthreads();
            }
            float cr[4];
#pragma unroll
            for (int e = 0; e < 4; ++e) cr[e] = dir == 0 ? __builtin_amdgcn_exp2f((float)(iq + e + 1) * l2f) : __builtin_amdgcn_exp2f((float)(128 - iq - e) * l2b);
#pragma unroll
            for (int nt = 0; nt < 8; nt += 2) {
                f32x4 t0 = (f32x4){0.f, 0.f, 0.f, 0.f}, t1 = t0;
#pragma unroll
                for (int ks = 0; ks < 4; ++ks) { const bf16x8 s0 = *(const LAS bf16x8*)(St + ((nt * 16 + r) * TS + ks * 32 + kq * 8) * 2), s1 = *(const LAS bf16x8*)(St + (((nt + 1) * 16 + r) * TS + ks * 32 + kq * 8) * 2);
                    t0 = mfma16(qf[ks], s0, t0); t1 = mfma16(qf[ks], s1, t1); }
#pragma unroll
                for (int e = 0; e < 4; ++e) { oi[nt][e] += cr[e] * t0[e]; oi[nt + 1][e] += cr[e] * t1[e]; }
                asm volatile("" ::: "memory");
            }
        }
        float ss[4];
#pragma unroll
        for (int e = 0; e < 4; ++e) { float s = 0.f;
#pragma unroll
            for (int nt = 0; nt < 8; ++nt) s += oi[nt][e] * oi[nt][e];
            s += __shfl_xor(s, 1); s += __shfl_xor(s, 2); s += __shfl_xor(s, 4); s += __shfl_xor(s, 8);
            ss[e] = rsqrtf(s * (1.0f / 128.0f) + EPS); }
#pragma unroll
        for (int nt = 0; nt < 8; ++nt)
#pragma unroll
            for (int e = 0; e < 4; ++e) *(LAS bf16*)(Pt + ((16 * wave + 4 * kq + e) * TS + nt * 16 + r) * 2) = (bf16)(pk2(oi[nt][e] * ss[e], 0.f) & 0xffffu);
        asm volatile("s_waitcnt lgkmcnt(0)" ::: "memory");
        { const int ln = kq * 16 + r, rw = ln >> 2, c4 = ln & 3, lrow = 16 * wave + rw; const float* rg = a.in[11] + h * 128 + c4 * 32;
#pragma unroll
            for (int k = 0; k < 4; ++k) { const v4u o8 = *(const LAS v4u*)(Pt + (lrow * TS + c4 * 32 + k * 8) * 2); const v4u g8 = pg_[k];
                const f32x4 r0 = *(const f32x4*)(rg + k * 8), r1 = *(const f32x4*)(rg + k * 8 + 4); const float rgv[8] = {r0.x, r0.y, r0.z, r0.w, r1.x, r1.y, r1.z, r1.w};
                v4u y;
#pragma unroll
                for (int w = 0; w < 4; ++w) { const float g0 = bflo(g8[w]), g1 = bfhi(g8[w]);
                    y[w] = pk2(g0 * pg8::fast_sigmoid(g0) * bflo(o8[w]) * rgv[2 * w], g1 * pg8::fast_sigmoid(g1) * bfhi(o8[w]) * rgv[2 * w + 1]); }
                *(v4u*)(YB + pg8::tiled_off(row0 + lrow, h * 128 + c4 * 32 + k * 8, D)) = y; }
            const int un = u + gridDim.x; if (un < 1280) { const bf16* gp = P + (size_t)((un >> 2) * 128 + lrow) * NAB + 1536 + (un & 3) * 128 + c4 * 32;
#pragma unroll
                for (int k = 0; k < 4; ++k) pg_[k] = *(const v4u*)(gp + k * 8); } }
    }
#endif
#ifndef NO_CONV
    {
        const float* cw = a.in[12]; const float* cbv = a.in[13];
        const int NT = gridDim.x * NTHREADS, gt = blockIdx.x * NTHREADS + tid0, c0 = (gt & 63) * 8;
        float w0[8], w1[8], w2[8], bb[8];
#pragma unroll
        for (int q = 0; q < 2; ++q) { const f32x4 t0 = *(const f32x4*)(cw + c0 + 4 * q), t1 = *(const f32x4*)(cw + 512 + c0 + 4 * q), t2 = *(const f32x4*)(cw + 1024 + c0 + 4 * q), t3 = *(const f32x4*)(cbv + c0 + 4 * q);
#pragma unroll
            for (int j = 0; j < 4; ++j) { w0[4 * q + j] = t0[j]; w1[4 * q + j] = t1[j]; w2[4 * q + j] = t2[j]; bb[4 * q + j] = t3[j]; } }
        for (int it = gt; it < (M / 4) * 64; it += NT) {
            const int m0 = (it >> 6) * 4;
            const int slen = m0 < MCTX ? 256 : 4096, pos0 = m0 < MCTX ? (m0 & 255) : ((m0 - MCTX) & 4095);
            const bf16* Pm = P + (size_t)m0 * NAB;
            v4u cg[6], xc[6], bg[4];
#pragma unroll
            for (int q = 0; q < 6; ++q) { const bool ok = (q == 0) ? (pos0 > 0) : ((q == 5) ? (pos0 + 4 < slen) : true);
                if (ok) { cg[q] = *(const v4u*)(Pm + (ptrdiff_t)(q - 1) * NAB + 2560 + c0); xc[q] = *(const v4u*)(Pm + (ptrdiff_t)(q - 1) * NAB + 3072 + c0); } else { cg[q] = (v4u){0u, 0u, 0u, 0u}; xc[q] = cg[q]; } }
#pragma unroll
            for (int q = 0; q < 4; ++q) bg[q] = *(const v4u*)(Pm + (size_t)q * NAB + 2048 + c0);
            float z[6][8];
#pragma unroll
            for (int q = 0; q < 6; ++q)
#pragma unroll
                for (int w = 0; w < 4; ++w) { z[q][2 * w] = bflo(cg[q][w]) * bflo(xc[q][w]); z[q][2 * w + 1] = bfhi(cg[q][w]) * bfhi(xc[q][w]); }
#pragma unroll
            for (int q = 0; q < 4; ++q) { v4u y;
#pragma unroll
                for (int w = 0; w < 4; ++w) {
                    const float y0 = bflo(bg[q][w]) * (w0[2 * w] * z[q][2 * w] + w1[2 * w] * z[q + 1][2 * w] + w2[2 * w] * z[q + 2][2 * w] + bb[2 * w]);
                    const float y1 = bfhi(bg[q][w]) * (w0[2 * w + 1] * z[q][2 * w + 1] + w1[2 * w + 1] * z[q + 1][2 * w + 1] + w2[2 * w + 1] * z[q + 2][2 * w + 1] + bb[2 * w + 1]);
                    y[w] = pk2(y0, y1); }
                *(v4u*)(YB + pg8::tiled_off(m0 + q, 512 + c0, D)) = y; }
        }
    }
#endif
}

__device__ __forceinline__ void spatial_phase(const Args& a, ldsp lds, int tid0, int lane, int wave) {
    const bf16* Z = (const bf16*)(a.ws + WS_P); bf16* YB = (bf16*)(a.ws + WS_YB); const float* vsq = (const float*)(a.ws + WS_VSQ);
    const float* w_s = a.in[17]; const float* b_s = a.in[18]; const float* vg = a.in[16];
    const ldsp At = lds, Vt = lds + TILE_B; LAS float* rs = (LAS float*)(lds + TILE_B + 128 * VS * 2);
    const int r0 = lane & 15, kq0 = lane >> 4;
    for (int u = blockIdx.x; u < 1280; u += gridDim.x) {
        const int cidx = u >> 2, g = u & 3, row0 = cidx * 128;
        int tid = tid0, r = r0, kq = kq0; asm volatile("" : "+v"(tid), "+v"(r), "+v"(kq));
        __syncthreads();
        if (tid < 128) { const f32x4* vp = (const f32x4*)(vsq + (size_t)(row0 + tid) * 16); const f32x4 s0 = vp[0], s1 = vp[1], s2 = vp[2], s3 = vp[3];
            const float s = ((s0.x + s0.y) + (s0.z + s0.w)) + ((s1.x + s1.y) + (s1.z + s1.w)) + ((s2.x + s2.y) + (s2.z + s2.w)) + ((s3.x + s3.y) + (s3.z + s3.w));
            rs[tid] = rsqrtf(s * (1.0f / 1024.0f) + EPS); }
#pragma unroll
        for (int rep = 0; rep < 8; ++rep) { const int it = tid + rep * NTHREADS, q = it >> 5, c = it & 31;
            *(LAS v4u*)(Vt + (q * VS + c * 8) * 2) = *(const v4u*)(Z + (size_t)(row0 + q) * NC + 1024 + g * 256 + c * 8); }
        __syncthreads();
#pragma unroll
        for (int rep = 0; rep < 4; ++rep) { const int it = tid + rep * NTHREADS, p = it >> 4, c = it & 15;
            const f32x4 w0 = *(const f32x4*)(w_s + (size_t)(g * 128 + p) * 128 + c * 8), w1 = *(const f32x4*)(w_s + (size_t)(g * 128 + p) * 128 + c * 8 + 4);
            const LAS float* rq = rs + c * 8;
            v4u o; o.x = pk2(w0.x * rq[0], w0.y * rq[1]); o.y = pk2(w0.z * rq[2], w0.w * rq[3]); o.z = pk2(w1.x * rq[4], w1.y * rq[5]); o.w = pk2(w1.z * rq[6], w1.w * rq[7]);
            *(LAS v4u*)(At + (p * TS + c * 8) * 2) = o; }
        __syncthreads();
        f32x4 acc[2][8];
#pragma unroll
        for (int n2 = 0; n2 < 2; ++n2)
#pragma unroll
            for (int mt = 0; mt < 8; ++mt) acc[n2][mt] = (f32x4){0.f, 0.f, 0.f, 0.f};
#pragma unroll
        for (int ks = 0; ks < 4; ++ks) { const int q0 = ks * 32 + kq * 8 + (r >> 2);
            const bf16x8 va0 = tr_frag(Vt + (q0 * VS + 32 * wave + 4 * (r & 3)) * 2, 8 * VS), va1 = tr_frag(Vt + (q0 * VS + 32 * wave + 16 + 4 * (r & 3)) * 2, 8 * VS);
#pragma unroll
            for (int mt = 0; mt < 8; ++mt) { const bf16x8 wf = *(const LAS bf16x8*)(At + ((mt * 16 + r) * TS + ks * 32 + kq * 8) * 2);
                acc[0][mt] = mfma16(va0, wf, acc[0][mt]); acc[1][mt] = mfma16(va1, wf, acc[1][mt]); } }
#pragma unroll
        for (int n2 = 0; n2 < 2; ++n2) { const int gch = g * 256 + 32 * wave + 16 * n2 + 4 * kq; const f32x4 vg4 = *(const f32x4*)(vg + gch);
#pragma unroll
            for (int mt = 0; mt < 8; ++mt) { const int p = mt * 16 + r; const float bsp = b_s[g * 128 + p];
                const v2u uu = *(const v2u*)(Z + (size_t)(row0 + p) * NC + gch);
                const float s0 = acc[n2][mt][0] * vg4.x + bsp, s1 = acc[n2][mt][1] * vg4.y + bsp, s2 = acc[n2][mt][2] * vg4.z + bsp, s3 = acc[n2][mt][3] * vg4.w + bsp;
                v2u y; y.x = pk2(bflo(uu.x) * s0, bfhi(uu.x) * s1); y.y = pk2(bflo(uu.y) * s2, bfhi(uu.y) * s3);
                *(v2u*)(YB + pg8::tiled_off(row0 + p, gch, D)) = y; } }
    }
}

__device__ __forceinline__ void shw_phase(const Args& a, int lane, int rw_lo, int rw_hi, int gw, int NGW) {
    unsigned char* ws = a.ws; const float* mod0 = (const float*)(ws + WS_MOD); const float* mod1 = mod0 + NCOND * MODW; float* shw = (float*)(ws + WS_SHW);
    for (int rw = rw_lo + gw; rw < rw_hi; rw += NGW) {
        const bf16* wrow; const float* sh; float* dst; int nb, n;
        if (rw < NGU) { n = rw; wrow = (const bf16*)(ws + WS_WGU); sh = mod0 + 3072; dst = shw; nb = NGU; }
        else if (rw < NGU + NC) { n = rw - NGU; wrow = (const bf16*)(ws + WS_WINC); sh = mod1; dst = shw + NCOND * NGU; nb = NC; }
        else { n = rw - NGU - NC; wrow = (const bf16*)(ws + WS_WGU) + (size_t)NGU * 1024; sh = mod1 + 3072; dst = shw + NCOND * (NGU + NC); nb = NGU; }
        const v4u w0 = *(const v4u*)(wrow + pg8::tiled_off_b(n, lane * 16, 1024)), w1 = *(const v4u*)(wrow + pg8::tiled_off_b(n, lane * 16 + 8, 1024));
        float wf[16];
#pragma unroll
        for (int q = 0; q < 4; ++q) { wf[2 * q] = bflo(w0[q]); wf[2 * q + 1] = bfhi(w0[q]); wf[8 + 2 * q] = bflo(w1[q]); wf[8 + 2 * q + 1] = bfhi(w1[q]); }
#pragma unroll
        for (int cb = 0; cb < NCOND; ++cb) { const f32x4* sp = (const f32x4*)(sh + (size_t)cb * MODW + lane * 16); float s = 0.f;
#pragma unroll
            for (int q = 0; q < 4; ++q) { const f32x4 t = sp[q]; s += (t.x * wf[4 * q] + t.y * wf[4 * q + 1]) + (t.z * wf[4 * q + 2] + t.w * wf[4 * q + 3]); }
            s = wave_sum(s); if (lane == 0) dst[(size_t)cb * nb + n] = s; }
    }
}

__device__ __forceinline__ void fn_row(const v4u x0, const v4u x1, float* yrow, const float* gn, int lane) {
    float v[16];
#pragma unroll
    for (int q = 0; q < 4; ++q) { v[2 * q] = bflo(x0[q]); v[2 * q + 1] = bfhi(x0[q]); v[8 + 2 * q] = bflo(x1[q]); v[8 + 2 * q + 1] = bfhi(x1[q]); }
    float s = 0.f;
#pragma unroll
    for (int q = 0; q < 16; ++q) s += v[q] * v[q];
    const float rstd = rsqrtf(wave_sum(s) * (1.0f / D) + EPS);
#pragma unroll
    for (int c = 0; c < 2; ++c) { const int col = 8 * lane + 512 * c; const f32x4 g0 = *(const f32x4*)(gn + col), g1 = *(const f32x4*)(gn + col + 4);
        *(f32x4*)(yrow + col) = (f32x4){v[8 * c] * rstd * g0.x, v[8 * c + 1] * rstd * g0.y, v[8 * c + 2] * rstd * g0.z, v[8 * c + 3] * rstd * g0.w};
        *(f32x4*)(yrow + col + 4) = (f32x4){v[8 * c + 4] * rstd * g1.x, v[8 * c + 5] * rstd * g1.y, v[8 * c + 6] * rstd * g1.z, v[8 * c + 7] * rstd * g1.w}; }
}
__device__ __forceinline__ void final_norm_direct(const bf16* src, int src_row0, float* y, const float* gn, int m_lo, int m_hi, int lane, int wave) {
    const int gw = blockIdx.x * NWAVES + wave, NGW = gridDim.x * NWAVES;
    for (int m = m_lo + gw; m < m_hi; m += 2 * NGW) { const int mb = m + NGW; const bool two = mb < m_hi;
        const bf16* xr = src + (size_t)(m - src_row0) * D + 8 * lane; const bf16* xs = src + (size_t)((two ? mb : m) - src_row0) * D + 8 * lane;
        const v4u x0 = *(const v4u*)xr, x1 = *(const v4u*)(xr + 512), z0 = *(const v4u*)xs, z1 = *(const v4u*)(xs + 512);
        fn_row(x0, x1, y + (size_t)m * D, gn, lane); if (two) fn_row(z0, z1, y + (size_t)mb * D, gn, lane); }
}
constexpr int FN_SPLIT = M / 2;
#define XB_TMO      128
#define XB_XCNT(j)  (256  + 64 * (j))
#define XB_XSUB(j)  (1280 + 64 * (j))
#define XB_XGEN(j)  (2304 + 64 * (j))
#define XB_TOP      3328
#define XB_TOPGEN   3392
#define XCD_BAR_WORDS 3456
#define XB_SPIN_CAP (1u << 18)

__device__ __forceinline__ unsigned xb_ld(unsigned* p)              { return __hip_atomic_load(p, __ATOMIC_RELAXED, __HIP_MEMORY_SCOPE_AGENT); }
__device__ __forceinline__ unsigned xb_add(unsigned* p, unsigned v) { return __hip_atomic_fetch_add(p, v, __ATOMIC_RELAXED, __HIP_MEMORY_SCOPE_AGENT); }
__device__ __forceinline__ unsigned xb_xcc_id() { return (unsigned)__builtin_amdgcn_s_getreg((3 << 11) | 20) & 0xFu; }
#define XB_SPIN(cond, bar) do { unsigned _sp = 0; while (cond) { __builtin_amdgcn_s_sleep(1); \
    if ((++_sp & 255u) == 0u) { if (xb_ld(&(bar)[XB_TMO])) break; if (_sp > XB_SPIN_CAP) { atomicAdd(&(bar)[XB_TMO], 1u); break; } } } } while (0)

struct XcdBarrier {
    unsigned* bar; unsigned x;
    volatile LAS unsigned* st;
};

__device__ __forceinline__ XcdBarrier xcd_barrier_post(unsigned* bar, volatile LAS unsigned* st) {
    XcdBarrier b; b.bar = bar; b.x = xb_xcc_id(); b.st = st;
    if (threadIdx.x == 0) (void)xb_add(&bar[XB_XCNT(b.x)], 1u);
    return b;
}
__device__ __forceinline__ void xcd_barrier_complete(unsigned* bar, unsigned x, unsigned& nloc, unsigned& nx) {
    const unsigned G = gridDim.x * gridDim.y * gridDim.z;
    unsigned sum, cnt, mine, sp = 0u;
    for (;;) {
        sum = 0u; cnt = 0u; mine = 0u;
#pragma unroll
        for (unsigned j = 0; j < 16; ++j) { const unsigned c = xb_ld(&bar[XB_XCNT(j)]); sum += c; cnt += (c > 0u) ? 1u : 0u; mine = (j == x) ? c : mine; }
        if (sum == G) break;
        __builtin_amdgcn_s_sleep(1);
        if ((++sp & 255u) == 0u) { if (xb_ld(&bar[XB_TMO])) break; if (sp > XB_SPIN_CAP) { atomicAdd(&bar[XB_TMO], 1u); break; } }
    }
    nloc = mine > 0u ? mine : 1u; nx = cnt > 0u ? cnt : 1u;
}

__device__ __forceinline__ void xcd_barrier(const XcdBarrier& b) {
    asm volatile("s_waitcnt vmcnt(0)" ::: "memory");
    __syncthreads();
    if (threadIdx.x == 0) {
        unsigned* bar = b.bar;
        __builtin_amdgcn_s_waitcnt(0);
        unsigned nloc = b.st[0], nx = b.st[1];
        if (nloc == 0u) { xcd_barrier_complete(bar, b.x, nloc, nx); b.st[0] = nloc; b.st[1] = nx; }
        const unsigned old = xb_add(&bar[XB_XSUB(b.x)], 1u);
        const unsigned gen = old / nloc;
        if (old + 1u == (gen + 1u) * nloc) {
            __builtin_amdgcn_fence(__ATOMIC_RELEASE, "agent");
            asm volatile("s_waitcnt vmcnt(0)" ::: "memory");
            const unsigned og = xb_add(&bar[XB_TOP], 1u);
            const unsigned tg = og / nx;
            if (og + 1u == (tg + 1u) * nx) xb_add(&bar[XB_TOPGEN], 1u);
            else XB_SPIN(xb_ld(&bar[XB_TOPGEN]) == tg, bar);
            __builtin_amdgcn_fence(__ATOMIC_ACQUIRE, "agent");
            xb_add(&bar[XB_XGEN(b.x)], 1u);
            asm volatile("s_waitcnt vmcnt(0)" ::: "memory");
        } else {
            XB_SPIN(xb_ld(&bar[XB_XGEN(b.x)]) == gen, bar);
            __builtin_amdgcn_fence(__ATOMIC_ACQUIRE, "agent");
            asm volatile("s_waitcnt vmcnt(0)" ::: "memory");
        }
    }
    __syncthreads();
}

__global__ void __launch_bounds__(NTHREADS, 2) mega_fwd(Args a) {
    extern __shared__ __attribute__((aligned(16))) unsigned char lds_raw[];
    const ldsp lds = (ldsp)lds_raw;
    const int tid = threadIdx.x, lane = tid & 63, wave = __builtin_amdgcn_readfirstlane(tid >> 6);
    unsigned char* ws = a.ws;
    float* mod0 = (float*)(ws + WS_MOD); float* mod1 = mod0 + NCOND * MODW;
    bf16* HB = (bf16*)(ws + WS_HB); bf16* YB = (bf16*)(ws + WS_YB); bf16* PB = (bf16*)(ws + WS_P);
    const int G = gridDim.x, bx = blockIdx.x;
#if ONE_LAUNCH
    volatile LAS unsigned* misc = (volatile LAS unsigned*)(lds + MISC_OFF);
    if (tid < 16) misc[tid] = 0u;
    __syncthreads();
    const XcdBarrier xbar = xcd_barrier_post((unsigned*)(ws + WS_BAR), misc);
#endif
#define IN(k) (((PH_MASK >> (k)) & 1) && a.ph_lo <= (k) && (k) < a.ph_hi)
#define INN(k) (a.ph_lo <= (k) && (k) < a.ph_hi)
#if ONE_LAUNCH
#define SEAM(k) do { if (INN(k) && INN((k) + 1)) xcd_barrier(xbar); } while (0)
#else
#define SEAM(k) do { } while (0)
#endif
#define STAGGER(ticks) do { if (ONE_LAUNCH && (ticks) > 0) { const unsigned long long t0_ = __builtin_amdgcn_s_memrealtime(); const unsigned long long dl_ = (unsigned long long)(((bx >> 3) & 31) * (ticks)) >> 5; \
        while (__builtin_amdgcn_s_memrealtime() - t0_ < dl_) __builtin_amdgcn_s_sleep(16); } } while (0)
#define GEMM(EpiT, Aop, Bop, Nn, Kk, Eobj) do { pg8::Gemm g_{(const pg8::bf16_t*)(Aop), (const pg8::bf16_t*)(Bop), M, (Nn), (Kk)}; pg8::StaticOrder S_; S_.init(M, (Nn), G, bx); \
        pg8::gemm_phase<EpiT, pg8::StaticOrder, true, true>(lds, g_, S_, (Eobj)); } while (0)

#if ONE_LAUNCH
    if (a.ph_lo < 0) cg::this_grid().sync();
#endif
    if (IN(0)) p0_prologue(a, lds, tid, lane, wave);
    SEAM(0);
    if (IN(1)) { norm_pass<true>(a, a.in[7], mod0, 0, 1024, HB, lane, wave); shw_phase(a, lane, 0, G == 256 ? NGU : 2 * NGU + NC, bx * NWAVES + wave, G * NWAVES); }
    SEAM(1);
    if (IN(2)) { pg8::EpiStoreBf16 E{PB, NAB}; GEMM(pg8::EpiStoreBf16, HB, ws + WS_WAB, NAB, 1024, E); }
    SEAM(2);
    if (IN(3)) r1_phase(a, lds, tid, lane, wave);
    SEAM(3);
    if (IN(4)) r2_phase(a, tid);
    SEAM(4);
    if (IN(5)) r3_phase(a, lds, tid, lane, wave);
    SEAM(5);
    float* rsq = (float*)(ws + WS_RSQ); const float* shw = (const float*)(ws + WS_SHW);
    bf16* XB0 = (bf16*)a.out; bf16* XB1 = XB0 + (size_t)M * D;
    typedef pg8::EpiResidB<true, true> EpiR0; typedef pg8::EpiResidB<false, true> EpiR1; typedef pg8::EpiResidB<false, false> EpiR2;
    if (IN(6)) { EpiR0 E{a.in[0], a.in[1], nullptr, XB0, mod0 + 2048, HB, a.in[8], mod0 + 4096, rsq}; GEMM(EpiR0, YB, ws + WS_WOAB, 1024, 1024, E);
        if (G == 256 && bx >= 128) convert_range(a, lds, CONV_EARLY, CONV_ALL, (bx - 128) * NWAVES + wave, 128 * NWAVES, lane, wave); }
    SEAM(6);
    if (IN(8)) { pg8::EpiSwiglu E{PB, FF, rsq, shw, NGU}; GEMM(pg8::EpiSwiglu, HB, ws + WS_WGU, NGU, 1024, E); }
    SEAM(8);
    if (IN(9)) { EpiR1 E{nullptr, nullptr, XB0, XB1, mod0 + 5120, HB, a.in[7] + D, mod1 + 1024, rsq}; GEMM(EpiR1, PB, ws + WS_WDN, 1024, FF, E);
        if (G == 256 && bx >= 128) shw_phase(a, lane, NGU, 2 * NGU + NC, (bx - 128) * NWAVES + wave, 128 * NWAVES); }
    SEAM(9);
    if (IN(11)) { pg8::EpiGeluSq E{PB, NC, (float*)(ws + WS_VSQ), 4, rsq, shw + NCOND * NGU, NC}; GEMM(pg8::EpiGeluSq, HB, ws + WS_WINC, NC, 1024, E); }
    SEAM(11);
    if (IN(12)) spatial_phase(a, lds, tid, lane, wave);
    SEAM(12);
    if (IN(13)) { EpiR1 E{nullptr, nullptr, XB1, XB0, mod1 + 2048, HB, a.in[8] + D, mod1 + 4096, rsq}; GEMM(EpiR1, YB, ws + WS_WOC, 1024, 1024, E); }
    SEAM(13);
    if (IN(15)) { pg8::EpiSwiglu E{PB, FF, rsq, shw + NCOND * (NGU + NC), NGU}; GEMM(pg8::EpiSwiglu, HB, ws + WS_WGU + (size_t)NGU * 1024 * 2, NGU, 1024, E); }
    SEAM(15);
    if (IN(16)) { EpiR2 E{nullptr, nullptr, XB0, HB, mod1 + 5120, nullptr, nullptr, nullptr, nullptr};
    GEMM(EpiR2, PB, ws + WS_WDN + (size_t)1024 * FF * 2, 1024, FF, E); }
    SEAM(16);
    if (IN(17)) final_norm_direct(HB, 0, a.out, a.in[23], 0, M, lane, wave);
#undef IN
#undef STAGGER
#undef SEAM
#undef GEMM
}

extern "C" void kernel_launch(void* const* d_in, const int* in_sizes, int n_in, void* d_out, int out_size, void* d_ws, size_t ws_size, hipStream_t stream) {
    static int grid = 0;
    if (grid == 0) {
        if (n_in != 24 || ws_size < WS_END) { fprintf(stderr, "kernel_launch: unexpected n_in %d / ws_size %zu\n", n_in, ws_size); grid = -1; return; }
        int dev = 0, cus = 0;
        if (hipGetDevice(&dev) != hipSuccess || hipDeviceGetAttribute(&cus, hipDeviceAttributeMultiprocessorCount, dev) != hipSuccess) { grid = -1; return; }
        if (hipFuncSetAttribute((const void*)mega_fwd, hipFuncAttributeMaxDynamicSharedMemorySize, LDS_BYTES) != hipSuccess) { fprintf(stderr, "kernel_launch: hipFuncSetAttribute failed\n"); grid = -1; return; }
        (void)hipGetLastError();
        grid = cus;
    }
    if (grid < 0) return;
    Args a{};
    for (int i = 0; i < 24; ++i) a.in[i] = (const float*)d_in[i];
    a.out = (float*)d_out; a.ws = (unsigned char*)d_ws;
#if ONE_LAUNCH
    if (hipMemsetAsync((char*)d_ws + WS_BAR, 0, XCD_BAR_WORDS * 4, stream) != hipSuccess) { fprintf(stderr, "kernel_launch: hipMemsetAsync failed\n"); return; }
    a.ph_lo = 0; a.ph_hi = N_PHASES;
    void* args[] = {&a};
    hipError_t e = hipLaunchCooperativeKernel((const void*)mega_fwd, dim3(grid), dim3(NTHREADS), args, LDS_BYTES, stream);
    if (e != hipSuccess) fprintf(stderr, "cooperative launch failed: %s (grid %d)\n", hipGetErrorString(e), grid);
#else
    for (int p = 0; p < N_PHASES; ++p) { a.ph_lo = p; a.ph_hi = p + 1; hipLaunchKernelGGL(mega_fwd, dim3(grid), dim3(NTHREADS), LDS_BYTES, stream, a); }
#endif
}
```

```cpp
#include <hip/hip_runtime.h>
#include <hip/hip_cooperative_groups.h>
#include <cstdio>
#include <cstdint>
namespace cg = cooperative_groups;
#ifndef PG8_AUX_A
#define PG8_AUX_A 0
#endif
#ifndef PG8_AUX_B
#define PG8_AUX_B 0
#endif
#ifndef PG8_PFD
#define PG8_PFD 5
#endif
namespace pg8 {
#define PG8_LAS __attribute__((address_space(3)))
typedef unsigned short bf16_t;
typedef short bf16x8 __attribute__((ext_vector_type(8)));
typedef float f32x4 __attribute__((ext_vector_type(4)));
typedef unsigned u32x4 __attribute__((ext_vector_type(4)));
typedef unsigned u32x2 __attribute__((ext_vector_type(2)));
constexpr int BM = 256, BK = 64, HALF = 128, HTB = HALF * BK * 2  , STAGE_BYTES = 8 * HTB, NXCD = 8, WGM = 4;

__host__ __device__ __forceinline__ int lds_byte(int r, int c) { const int st = (r >> 4) * 2 + (c >> 5), rr = r & 15, cc = c & 31, ob = rr * 64 + cc * 2; return st * 1024 + (ob ^ (((ob >> 9) & 1) << 5)); }
__host__ __device__ __forceinline__ void stage_rc(int b, int& R, int& C) { const int st = b / 1024, sb = b % 1024, swz = sb ^ (((sb >> 9) & 1) << 5); R = (st >> 1) * 16 + swz / 64; C = (st & 1) * 32 + (swz % 64) / 2; }
__host__ __device__ __forceinline__ int perm32(int rho) { const int n = rho >> 4, i = rho & 15; return 8 * (i >> 2) + 4 * n + (i & 3); }

__host__ __device__ __forceinline__ int invperm32(int x) { return ((x >> 2) & 1) * 16 + (x >> 3) * 4 + (x & 3); }
__host__ __device__ __forceinline__ size_t tiled_off(int m, int k, int K) { return ((((size_t)(m >> 8) * (size_t)(K >> 6)) + (size_t)(k >> 6)) << 14) + (size_t)(((m >> 7) & 1) << 13) + (size_t)(lds_byte(m & 127, k & 63) >> 1); }
__host__ __device__ __forceinline__ size_t tiled_off_b(int n, int k, int K) { const int r = n & 127, R = (r & ~31) + invperm32(r & 31); return ((((size_t)(n >> 8) * (size_t)(K >> 6)) + (size_t)(k >> 6)) << 14) + (size_t)(((n >> 7) & 1) << 13) + (size_t)(lds_byte(R, k & 63) >> 1); }
struct Unit { int pm, pn; };
struct Gemm { const bf16_t* A; const bf16_t* Bt; int M, N, K; };

struct StaticOrder {
    int nM, nN, nwg, G, c;
    __host__ __device__ void init(int M, int N, int G_, int c_) { nM = M / BM; nN = N / BM; nwg = nM * nN; G = G_; c = c_; }
    __host__ __device__ bool next(int i, Unit& u) const {
        const long L = (long)i * G + c; if (L >= nwg) return false;
        int wgid = (int)L; { const int q = nwg / NXCD, r = nwg % NXCD, xcd = wgid % NXCD, off = wgid / NXCD; wgid = (xcd < r ? xcd * (q + 1) : r * (q + 1) + (xcd - r) * q) + off; }
        const int nig = WGM * nN, gid = wgid / nig, fm = gid * WGM, gsz = (nM - fm) < WGM ? (nM - fm) : WGM;
        u.pm = fm + ((wgid % nig) % gsz); u.pn = (wgid % nig) / gsz; return true;
    }
    __device__ __forceinline__ void a_ready(const Unit&) const {}
    __device__ __forceinline__ void done(const Unit&) const {}
};

typedef float f32x2_cv __attribute__((ext_vector_type(2))); typedef __bf16 bf16x2_cv __attribute__((ext_vector_type(2)));
__device__ __forceinline__ unsigned cvt_pk_bf16(float lo, float hi) { const f32x2_cv v = {lo, hi}; const bf16x2_cv b = __builtin_convertvector(v, bf16x2_cv); return __builtin_bit_cast(unsigned, b); }
typedef float f32x2 __attribute__((ext_vector_type(2)));
__device__ __forceinline__ float fast_sigmoid(float x) { return __builtin_amdgcn_rcpf(1.0f + __builtin_amdgcn_exp2f(-1.4426950408889634f * x)); }
struct EpiStoreBf16 {
    static constexpr bool PERM = true, AFTER_DRAIN = false;
    bf16_t* O; int ldc;
    __device__ __forceinline__ void operator()(const f32x4 (&acc)[2][2][4][2], const Unit& u, int wr, int wc, int fr, int fq) const {
        const int row0 = u.pm * BM + wr * 64 + fr, col0 = u.pn * BM + wc * 32 + 8 * fq;
#pragma unroll
        for (int ai = 0; ai < 2; ++ai)
#pragma unroll
            for (int m = 0; m < 4; ++m) { bf16_t* rowp = O + (size_t)(row0 + ai * HALF + m * 16) * ldc + col0;
#pragma unroll
                for (int bj = 0; bj < 2; ++bj) { const f32x4 v0 = acc[ai][bj][m][0], v1 = acc[ai][bj][m][1];
                    u32x4 w; w.x = cvt_pk_bf16(v0[0], v0[1]); w.y = cvt_pk_bf16(v0[2], v0[3]); w.z = cvt_pk_bf16(v1[0], v1[1]); w.w = cvt_pk_bf16(v1[2], v1[3]);
                    *(u32x4*)(rowp + bj * HALF) = w; } }
    }
};
__device__ __forceinline__ void load_rstd(const float* rsq, int row0, int fq, float (&rstd)[2][4]) {
#pragma unroll
    for (int ai = 0; ai < 2; ++ai)
#pragma unroll
        for (int m = 0; m < 4; ++m) { const f32x4 p = *(const f32x4*)(rsq + (size_t)(row0 + ai * HALF + m * 16) * 16 + 4 * fq); float s = (p[0] + p[1]) + (p[2] + p[3]);
            s += __shfl_xor(s, 16); s += __shfl_xor(s, 32); rstd[ai][m] = rsqrtf(s * (1.0f / 1024.0f) + 1e-6f); }
}
struct EpiGeluSq {
    static constexpr bool PERM = true, AFTER_DRAIN = false;
    bf16_t* O; int ldc; float* vsq; int pn_v; const float* rsq; const float* bias; int nbias;
    __device__ __forceinline__ void operator()(const f32x4 (&acc)[2][2][4][2], const Unit& u, int wr, int wc, int fr, int fq) const {
        const int row0 = u.pm * BM + wr * 64 + fr, col0 = u.pn * BM + wc * 32 + 8 * fq;
        const int cb = u.pm < 32 ? 0 : 1 + ((u.pm - 32) >> 4);
        float rstd[2][4]; load_rstd(rsq, row0, fq, rstd);
        f32x4 bv[2][2];
#pragma unroll
        for (int bj = 0; bj < 2; ++bj)
#pragma unroll
            for (int n = 0; n < 2; ++n) bv[bj][n] = *(const f32x4*)(bias + (size_t)cb * nbias + col0 + bj * HALF + 4 * n);
#pragma unroll
        for (int ai = 0; ai < 2; ++ai)
#pragma unroll
            for (int m = 0; m < 4; ++m) { const int row = row0 + ai * HALF + m * 16; bf16_t* rowp = O + (size_t)row * ldc + col0; float ss = 0.f;
#pragma unroll
                for (int bj = 0; bj < 2; ++bj) { f32x4 v[2];
#pragma unroll
                    for (int n = 0; n < 2; ++n)
#pragma unroll
                        for (int j = 0; j < 4; ++j) { const float x = acc[ai][bj][m][n][j] * rstd[ai][m] + bv[bj][n][j];
                            const float gl = x * __builtin_amdgcn_rcpf(1.0f + __builtin_amdgcn_exp2f(x * (x * x * -0.10294324f + -2.3022082f))); v[n][j] = gl; ss += gl * gl; }
                    u32x4 w; w.x = cvt_pk_bf16(v[0][0], v[0][1]); w.y = cvt_pk_bf16(v[0][2], v[0][3]); w.z = cvt_pk_bf16(v[1][0], v[1][1]); w.w = cvt_pk_bf16(v[1][2], v[1][3]);
                    *(u32x4*)(rowp + bj * HALF) = w; }
                ss += __shfl_xor(ss, 16); ss += __shfl_xor(ss, 32);
                if (u.pn >= pn_v && fq == 0) vsq[(size_t)row * 16 + (u.pn - pn_v) * 4 + wc] = ss; }
    }
};
struct EpiSwiglu {
    static constexpr bool PERM = true, AFTER_DRAIN = false;
    bf16_t* O; int ldc; const float* rsq; const float* bias; int nbias;
    __device__ __forceinline__ void operator()(const f32x4 (&acc)[2][2][4][2], const Unit& u, int wr, int wc, int fr, int fq) const {
        const int row0 = u.pm * BM + wr * 64 + fr, col0 = u.pn * HALF + wc * 32 + 8 * fq;
        const int cb = u.pm < 32 ? 0 : 1 + ((u.pm - 32) >> 4);
        float rstd[2][4]; load_rstd(rsq, row0, fq, rstd);
        f32x4 bv[2][2];
#pragma unroll
        for (int bj = 0; bj < 2; ++bj)
#pragma unroll
            for (int n = 0; n < 2; ++n) bv[bj][n] = *(const f32x4*)(bias + (size_t)cb * nbias + u.pn * BM + bj * HALF + wc * 32 + 8 * fq + 4 * n);
#pragma unroll
        for (int ai = 0; ai < 2; ++ai)
#pragma unroll
            for (int m = 0; m < 4; ++m) { bf16_t* rowp = O + tiled_off(row0 + ai * HALF + m * 16, col0, ldc); f32x4 v[2];
#pragma unroll
                for (int n = 0; n < 2; ++n)
#pragma unroll
                    for (int j = 0; j < 4; ++j) { const float g = acc[ai][0][m][n][j] * rstd[ai][m] + bv[0][n][j], up = acc[ai][1][m][n][j] * rstd[ai][m] + bv[1][n][j]; v[n][j] = g * fast_sigmoid(g) * up; }
                u32x4 w; w.x = cvt_pk_bf16(v[0][0], v[0][1]); w.y = cvt_pk_bf16(v[0][2], v[0][3]); w.z = cvt_pk_bf16(v[1][0], v[1][1]); w.w = cvt_pk_bf16(v[1][2], v[1][3]);
                *(u32x4*)rowp = w; }
    }
};
template <bool F32BASE, bool NORM> struct EpiResidB {
    static constexpr bool PERM = true, AFTER_DRAIN = false;
    const float* b0; const float* b1; const bf16_t* XI; bf16_t* XO; const float* gate; bf16_t* A; const float* gn; const float* sc; float* rsq;
    __device__ __forceinline__ void operator()(const f32x4 (&acc)[2][2][4][2], const Unit& u, int wr, int wc, int fr, int fq) const {
        const int cb = u.pm < 32 ? 0 : 1 + ((u.pm - 32) >> 4);
        const int row0 = u.pm * BM + wr * 64 + fr, col0 = u.pn * BM + wc * 32 + 8 * fq;
        const float* bf = u.pm < 32 ? b0 : b1 - (size_t)8192 * 1024;
        f32x4 gv[2][2], gm[2][2];
#pragma unroll
        for (int bj = 0; bj < 2; ++bj)
#pragma unroll
            for (int n = 0; n < 2; ++n) { const int c = col0 + bj * HALF + 4 * n; gv[bj][n] = *(const f32x4*)(gate + cb * 6144 + c);
                if (NORM) gm[bj][n] = *(const f32x4*)(gn + c) * (*(const f32x4*)(sc + cb * 6144 + c) + 1.0f); }
#pragma unroll
        for (int ai = 0; ai < 2; ++ai)
#pragma unroll
            for (int m = 0; m < 4; ++m) { const int row = row0 + ai * HALF + m * 16; float ss = 0.f;
#pragma unroll
                for (int bj = 0; bj < 2; ++bj) { const size_t off = (size_t)row * 1024 + col0 + bj * HALF; f32x4 x0, x1;
                    if (F32BASE) { x0 = *(const f32x4*)(bf + off); x1 = *(const f32x4*)(bf + off + 4); }
                    else { const u32x4 w = *(const u32x4*)(XI + off); x0 = (f32x4){__uint_as_float(w.x << 16), __uint_as_float(w.x & 0xffff0000u), __uint_as_float(w.y << 16), __uint_as_float(w.y & 0xffff0000u)};
                        x1 = (f32x4){__uint_as_float(w.z << 16), __uint_as_float(w.z & 0xffff0000u), __uint_as_float(w.w << 16), __uint_as_float(w.w & 0xffff0000u)}; }
                    x0 = x0 + gv[bj][0] * acc[ai][bj][m][0]; x1 = x1 + gv[bj][1] * acc[ai][bj][m][1];
                    u32x4 o; o.x = cvt_pk_bf16(x0[0], x0[1]); o.y = cvt_pk_bf16(x0[2], x0[3]); o.z = cvt_pk_bf16(x1[0], x1[1]); o.w = cvt_pk_bf16(x1[2], x1[3]);
                    *(u32x4*)(XO + off) = o;
                    if (NORM) { ss += ((x0[0] * x0[0] + x0[1] * x0[1]) + (x0[2] * x0[2] + x0[3] * x0[3])) + ((x1[0] * x1[0] + x1[1] * x1[1]) + (x1[2] * x1[2] + x1[3] * x1[3]));
                        const f32x4 a0 = x0 * gm[bj][0], a1 = x1 * gm[bj][1];
                        u32x4 q; q.x = cvt_pk_bf16(a0[0], a0[1]); q.y = cvt_pk_bf16(a0[2], a0[3]); q.z = cvt_pk_bf16(a1[0], a1[1]); q.w = cvt_pk_bf16(a1[2], a1[3]);
                        *(u32x4*)(A + tiled_off(row, col0 + bj * HALF, 1024)) = q; } }
                if (NORM) { ss += __shfl_xor(ss, 16); ss += __shfl_xor(ss, 32); if (fq == 0) rsq[(size_t)row * 16 + u.pn * 4 + wc] = ss; } }
    }
};
template <class Epi, class Sched, bool ALIGN_EPI = false, bool SP2 = false>
__device__ __forceinline__ void gemm_phase(PG8_LAS unsigned char* lds, const Gemm g, const Sched& S, const Epi& E) {
    const int tid = threadIdx.x, wid = __builtin_amdgcn_readfirstlane(tid >> 6), lane = tid & 63, wr = wid >> 2, wc = wid & 3, fr = lane & 15, fq = lane >> 4;
    const int K = g.K, nt = K / BK;
    unsigned voffA[2], voffB[2];
#pragma unroll
    for (int i = 0; i < 2; ++i) { voffA[i] = (unsigned)(tid * 16 + i * 8192); voffB[i] = voffA[i]; }
    const size_t kstep = (size_t)(BM * BK * 2);
    const size_t hstep = (size_t)HALF * BK * 2;
    const size_t tstep = (size_t)BM * K * 2;
    const unsigned ldsw = (unsigned)wid * 1024u;
    const int aoff = lds_byte(wr * 64 + fr, fq * 8), boff = lds_byte(wc * 32 + fr, fq * 8);
#define PG8_SA(b, h) (((b) * 2 + (h)) * HTB)
#define PG8_SB(b, h) ((4 + (b) * 2 + (h)) * HTB)
#define PG8_STAGE(bufoff, gbase, voff) do { _Pragma("unroll") for (int _i = 0; _i < 2; ++_i) { \
        if ((bufoff) >= 4 * HTB) __builtin_amdgcn_global_load_lds((const unsigned*)((const char*)(gbase) + (voff)[_i]), (PG8_LAS unsigned*)(lds + (bufoff) + ldsw + _i * 8192), 16, 0, PG8_AUX_B); \
        else __builtin_amdgcn_global_load_lds((const unsigned*)((const char*)(gbase) + (voff)[_i]), (PG8_LAS unsigned*)(lds + (bufoff) + ldsw + _i * 8192), 16, 0, PG8_AUX_A); } } while (0)
#define PG8_LDA(dst, b, h) do { _Pragma("unroll") for (int m = 0; m < 4; ++m) _Pragma("unroll") for (int k = 0; k < 2; ++k) dst[m][k] = *(const PG8_LAS bf16x8*)(lds + PG8_SA(b, h) + aoff + m * 2048 + k * 1024); } while (0)
#define PG8_LDB(dst, b, h) do { _Pragma("unroll") for (int n = 0; n < 2; ++n) _Pragma("unroll") for (int k = 0; k < 2; ++k) dst[n][k] = *(const PG8_LAS bf16x8*)(lds + PG8_SB(b, h) + boff + n * 2048 + k * 1024); } while (0)
#define PG8_MMA(ai, bj, At, Bt) do { __builtin_amdgcn_s_setprio(1); _Pragma("unroll") for (int m = 0; m < 4; ++m) _Pragma("unroll") for (int n = 0; n < 2; ++n) _Pragma("unroll") for (int k = 0; k < 2; ++k) \
        acc[ai][bj][m][n] = __builtin_amdgcn_mfma_f32_16x16x32_bf16(Bt[n][k], At[m][k], acc[ai][bj][m][n], 0, 0, 0); __builtin_amdgcn_s_setprio(0); } while (0)
#define PG8_WAIT_V(n) asm volatile("s_waitcnt vmcnt(" #n ")" ::: "memory")
#define PG8_WAIT_L(n) asm volatile("s_waitcnt lgkmcnt(" #n ")" ::: "memory")
#define PG8_BAR __builtin_amdgcn_s_barrier()
#define PG8_SCHED __builtin_amdgcn_sched_barrier(0)
    Unit cur, nxt; int ui = 0;
    if (!S.next(0, cur)) return;
    f32x4 acc[2][2][4][2];
#pragma unroll
    for (int a = 0; a < 2; ++a)
#pragma unroll
        for (int b = 0; b < 2; ++b)
#pragma unroll
            for (int m = 0; m < 4; ++m)
#pragma unroll
                for (int n = 0; n < 2; ++n) acc[a][b][m][n] = (f32x4){0.f, 0.f, 0.f, 0.f};
    bf16x8 At[4][2], B0[2][2], B1[2][2];
    const char* cA = (const char*)g.A + (size_t)cur.pm * tstep; const char* cB = (const char*)g.Bt + (size_t)cur.pn * tstep;
    S.a_ready(cur);
    if constexpr (SP2) {
        PG8_STAGE(PG8_SB(0, 0), cB, voffB); PG8_STAGE(PG8_SB(0, 1), cB + hstep, voffB); PG8_STAGE(PG8_SA(0, 0), cA, voffA); PG8_STAGE(PG8_SA(0, 1), cA + hstep, voffA);
        if (wr == 1) PG8_BAR;
        PG8_WAIT_V(2); PG8_BAR;
        PG8_STAGE(PG8_SB(1, 0), cB + kstep, voffB); PG8_STAGE(PG8_SA(1, 0), cA + kstep, voffA); PG8_STAGE(PG8_SB(1, 1), cB + hstep + kstep, voffB);
        PG8_WAIT_V(6); PG8_BAR;
    } else {
        PG8_STAGE(PG8_SB(0, 0), cB, voffB); PG8_STAGE(PG8_SA(0, 0), cA, voffA); PG8_STAGE(PG8_SB(0, 1), cB + hstep, voffB); PG8_STAGE(PG8_SA(0, 1), cA + hstep, voffA);
        if (wr == 1) PG8_BAR;
        PG8_WAIT_V(4); PG8_BAR;
        PG8_STAGE(PG8_SB(1, 0), cB + kstep, voffB); PG8_STAGE(PG8_SA(1, 0), cA + kstep, voffA); PG8_STAGE(PG8_SB(1, 1), cB + hstep + kstep, voffB);
        PG8_WAIT_V(6); PG8_BAR;
    }
    for (;;) {
        const bool has_next = S.next(ui + 1, nxt);
        const char* nA = has_next ? (const char*)g.A + (size_t)nxt.pm * tstep : cA; const char* nB = has_next ? (const char*)g.Bt + (size_t)nxt.pn * tstep : cB;
        for (int t = 0; t < nt; t += 2) {
            const bool last = (t == nt - 2);
            const char* a1 = cA + (size_t)(t + 1) * kstep;
            const char* a2 = last ? nA : cA + (size_t)(t + 2) * kstep; const char* b2 = last ? nB : cB + (size_t)(t + 2) * kstep;
            const char* a3 = a2 + kstep; const char* b3 = b2 + kstep;
            if (last && has_next) S.a_ready(nxt);
            if constexpr (SP2) {
            PG8_LDB(B0, 0, 0); PG8_LDB(B1, 0, 1); PG8_SCHED; PG8_LDA(At, 0, 0); PG8_STAGE(PG8_SA(1, 1), a1 + hstep, voffA);
            PG8_WAIT_V(8); PG8_WAIT_L(0); PG8_BAR; PG8_MMA(0, 0, At, B0); PG8_MMA(0, 1, At, B1); PG8_BAR; PG8_SCHED;
            PG8_LDA(At, 0, 1); PG8_STAGE(PG8_SB(0, 0), b2, voffB); PG8_STAGE(PG8_SB(0, 1), b2 + hstep, voffB); PG8_STAGE(PG8_SA(0, 0), a2, voffA);
            PG8_WAIT_V(8); PG8_WAIT_L(0); PG8_BAR; PG8_MMA(1, 0, At, B0); PG8_MMA(1, 1, At, B1); PG8_BAR; PG8_SCHED;
            PG8_LDB(B0, 1, 0); PG8_LDB(B1, 1, 1); PG8_SCHED; PG8_LDA(At, 1, 0); PG8_STAGE(PG8_SA(0, 1), a2 + hstep, voffA);
            PG8_WAIT_V(8); PG8_WAIT_L(0); PG8_BAR; PG8_MMA(0, 0, At, B0); PG8_MMA(0, 1, At, B1); PG8_BAR; PG8_SCHED;
            PG8_LDA(At, 1, 1); PG8_STAGE(PG8_SB(1, 0), b3, voffB); PG8_STAGE(PG8_SB(1, 1), b3 + hstep, voffB); PG8_STAGE(PG8_SA(1, 0), a3, voffA);
            PG8_WAIT_V(8); PG8_WAIT_L(0); PG8_BAR; PG8_MMA(1, 0, At, B0); PG8_MMA(1, 1, At, B1); PG8_BAR; PG8_SCHED;
            } else {
            PG8_LDB(B0, 0, 0); PG8_SCHED; PG8_LDA(At, 0, 0); PG8_STAGE(PG8_SA(1, 1), a1 + hstep, voffA);
            PG8_WAIT_L(8); PG8_BAR; PG8_WAIT_L(0); PG8_MMA(0, 0, At, B0); PG8_BAR; PG8_SCHED;
            PG8_LDB(B1, 0, 1); PG8_STAGE(PG8_SB(0, 0), b2, voffB);
            PG8_BAR; PG8_WAIT_L(0); PG8_MMA(0, 1, At, B1); PG8_BAR;
            PG8_LDA(At, 0, 1); PG8_STAGE(PG8_SA(0, 0), a2, voffA);
            PG8_BAR; PG8_WAIT_L(0); PG8_MMA(1, 0, At, B0); PG8_BAR; PG8_SCHED;
            PG8_STAGE(PG8_SB(0, 1), b2 + hstep, voffB);
            PG8_WAIT_V(6); PG8_BAR; PG8_MMA(1, 1, At, B1); PG8_BAR;
            PG8_LDB(B0, 1, 0); PG8_SCHED; PG8_LDA(At, 1, 0); PG8_STAGE(PG8_SA(0, 1), a2 + hstep, voffA);
            PG8_WAIT_L(8); PG8_BAR; PG8_WAIT_L(0); PG8_MMA(0, 0, At, B0); PG8_BAR; PG8_SCHED;
            PG8_LDB(B1, 1, 1); PG8_STAGE(PG8_SB(1, 0), b3, voffB);
            PG8_BAR; PG8_WAIT_L(0); PG8_MMA(0, 1, At, B1); PG8_BAR;
            PG8_LDA(At, 1, 1); PG8_STAGE(PG8_SA(1, 0), a3, voffA);
            PG8_BAR; PG8_WAIT_L(0); PG8_MMA(1, 0, At, B0); PG8_BAR; PG8_SCHED;
            PG8_STAGE(PG8_SB(1, 1), b3 + hstep, voffB);
            PG8_WAIT_V(6); PG8_BAR; PG8_MMA(1, 1, At, B1); PG8_BAR;
            }
        }
        if constexpr (ALIGN_EPI) { if (wr == 0) PG8_BAR; }
        if constexpr (!Epi::AFTER_DRAIN) { E(acc, cur, wr, wc, fr, fq); S.done(cur); }
        if (!has_next) break;
#pragma unroll
        for (int a = 0; a < 2; ++a)
#pragma unroll
            for (int b = 0; b < 2; ++b)
#pragma unroll
                for (int m = 0; m < 4; ++m)
#pragma unroll
                    for (int n = 0; n < 2; ++n) acc[a][b][m][n] = (f32x4){0.f, 0.f, 0.f, 0.f};
        cur = nxt; cA = nA; cB = nB; ++ui;
        if constexpr (ALIGN_EPI) { if (wr == 1) PG8_BAR; }
    }
    PG8_WAIT_V(0);
    if constexpr (!ALIGN_EPI) { if (wr == 0) PG8_BAR; }
    PG8_BAR;
    if constexpr (Epi::AFTER_DRAIN) { E.fused(acc, cur, wr, wc, fr, fq, lds, wid, lane); S.done(cur); }
#undef PG8_SA
#undef PG8_SB
#undef PG8_STAGE
#undef PG8_LDA
#undef PG8_LDB
#undef PG8_MMA
#undef PG8_WAIT_V
#undef PG8_WAIT_L
#undef PG8_BAR
#undef PG8_SCHED
}
}
constexpr int D = 1024, MCTX = 8192, MLAT = 32768, M = MCTX + MLAT;
constexpr int NAB = 3584, FF = 2816, NGU = 2 * FF, NC = 2048, NCOND = 9, MODW = 6 * D;
constexpr float EPS = 1e-6f;
constexpr int NWAVES = 8, NTHREADS = 512;
#ifndef ONE_LAUNCH
#define ONE_LAUNCH 1
#endif
constexpr int N_PHASES = 18;
#ifndef PH_MASK
#define PH_MASK 0x3ffff
#endif
#ifndef STAG_TICKS
#define STAG_TICKS 0
#endif
#ifndef ONE_LAUNCH
#define ONE_LAUNCH 1
#endif
constexpr size_t MiB = 1u << 20;
constexpr size_t WS_MOD = 0;
constexpr size_t WS_ROPE = 1 * MiB;
constexpr size_t WS_VSQ = 2 * MiB;
constexpr size_t WS_SHW = 512 * 1024;
constexpr size_t WS_RSQ = 4 * MiB + 512 * 1024;
constexpr size_t WS_BAR = 7 * MiB + 512 * 1024;
constexpr size_t WS_WAB = 8 * MiB;
constexpr size_t WS_WOAB = 15 * MiB;
constexpr size_t WS_WINC = 17 * MiB;
constexpr size_t WS_WOC = 21 * MiB;
constexpr size_t WS_WGU = 23 * MiB;
constexpr size_t WS_WDN = 45 * MiB;
constexpr size_t WS_HB = 56 * MiB;
constexpr size_t WS_YB = 136 * MiB;
constexpr size_t WS_P = 216 * MiB;
constexpr size_t WS_END = 496 * MiB;
constexpr int LDS_BYTES = 147456;
constexpr int MISC_OFF = LDS_BYTES - 64;
constexpr int TS = 136, TILE_B = 128 * TS * 2;
constexpr int VS = 264;

#define LAS __attribute__((address_space(3)))
typedef unsigned short bf16;
typedef unsigned v4u __attribute__((ext_vector_type(4)));
typedef unsigned v2u __attribute__((ext_vector_type(2)));
typedef float f32x4 __attribute__((ext_vector_type(4)));
typedef short bf16x8 __attribute__((ext_vector_type(8)));
typedef short s16x4 __attribute__((ext_vector_type(4)));
typedef LAS unsigned char* ldsp;

__device__ __forceinline__ float bflo(unsigned w) { return __uint_as_float(w << 16); }
__device__ __forceinline__ float bfhi(unsigned w) { return __uint_as_float(w & 0xffff0000u); }
__device__ __forceinline__ unsigned pk2(float lo, float hi) { return pg8::cvt_pk_bf16(lo, hi); }
__device__ __forceinline__ s16x4 vtr(const LAS unsigned char* p) { return __builtin_bit_cast(s16x4, __builtin_amdgcn_ds_read_tr16_b64_v4i16((LAS s16x4*)p)); }
__device__ __forceinline__ bf16x8 tr_frag(const LAS unsigned char* p, int off2) { const s16x4 a = vtr(p), b = vtr(p + off2); return __builtin_shufflevector(a, b, 0, 1, 2, 3, 4, 5, 6, 7); }
__device__ __forceinline__ f32x4 mfma16(bf16x8 a, bf16x8 b, f32x4 c) { return __builtin_amdgcn_mfma_f32_16x16x32_bf16(a, b, c, 0, 0, 0); }
__device__ __forceinline__ float wave_sum(float v) {
#pragma unroll
    for (int o = 1; o < 64; o <<= 1) v += __shfl_xor(v, o);
    return v;
}
__device__ __forceinline__ float log2_sigmoid(float x) { return -log1pf(expf(-x)) * 1.4426950408889634f; }

struct Args {
    const float* in[24]; float* out; unsigned char* ws; int ph_lo, ph_hi;
};

__device__ __forceinline__ void transpose_item(const float* W, int K, int N, bf16* WT, int k0, int n0, int dst_row0, float scale, LAS float* scr, int lane) {
    float wv[32];
#pragma unroll
    for (int i = 0; i < 32; ++i) wv[i] = W[(size_t)(k0 + 2 * i + (lane >> 5)) * N + n0 + (lane & 31)];
#pragma unroll
    for (int i = 0; i < 32; ++i) scr[(2 * i + (lane >> 5)) * 33 + (lane & 31)] = wv[i];
    asm volatile("s_waitcnt lgkmcnt(0)" ::: "memory");
    const int c = lane & 7;
#pragma unroll
    for (int j = 0; j < 4; ++j) { const int n = (lane >> 3) + 8 * j; const LAS float* s = scr + (8 * c) * 33 + n;
        v4u o; o.x = pk2(s[0 * 33] * scale, s[1 * 33] * scale); o.y = pk2(s[2 * 33] * scale, s[3 * 33] * scale); o.z = pk2(s[4 * 33] * scale, s[5 * 33] * scale); o.w = pk2(s[6 * 33] * scale, s[7 * 33] * scale);
        *(v4u*)(WT + pg8::tiled_off_b(dst_row0 + n, k0 + 8 * c, K)) = o; }
    asm volatile("s_waitcnt lgkmcnt(0)" ::: "memory");
}

constexpr int CONV_EARLY = 5120, CONV_ALL = 12288;
__device__ __forceinline__ void convert_range(const Args& a, ldsp lds, int it_lo, int it_hi, int gw, int NGW, int lane, int wave) {
    unsigned char* ws = a.ws; LAS float* scr = (LAS float*)lds + wave * (64 * 33);
    for (int it = it_lo + gw; it < it_hi; it += NGW) {
        int r = it; const float* W; int K, N; bf16* WT; int mode = 0;
        if (r < 1792) { W = a.in[9]; K = 1024; N = NAB; WT = (bf16*)(ws + WS_WAB); mode = 3; }
        else if ((r -= 1792) < 512) { W = a.in[14]; K = 1024; N = 1024; WT = (bf16*)(ws + WS_WOAB); }
        else if ((r -= 512) < 1408) { W = a.in[20]; K = 1024; N = FF; WT = (bf16*)(ws + WS_WGU); mode = 1; }
        else if ((r -= 1408) < 1408) { W = a.in[21]; K = 1024; N = FF; WT = (bf16*)(ws + WS_WGU); mode = 2; }
        else if ((r -= 1408) < 1408) { W = a.in[22]; K = FF; N = 1024; WT = (bf16*)(ws + WS_WDN); }
        else if ((r -= 1408) < 1024) { W = a.in[15]; K = 1024; N = NC; WT = (bf16*)(ws + WS_WINC); }
        else if ((r -= 1024) < 512) { W = a.in[19]; K = 1024; N = 1024; WT = (bf16*)(ws + WS_WOC); }
        else if ((r -= 512) < 1408) { W = a.in[20] + (size_t)1024 * FF; K = 1024; N = FF; WT = (bf16*)(ws + WS_WGU) + (size_t)NGU * 1024; mode = 1; }
        else if ((r -= 1408) < 1408) { W = a.in[21] + (size_t)1024 * FF; K = 1024; N = FF; WT = (bf16*)(ws + WS_WGU) + (size_t)NGU * 1024; mode = 2; }
        else { r -= 1408; W = a.in[22] + (size_t)FF * 1024; K = FF; N = 1024; WT = (bf16*)(ws + WS_WDN) + (size_t)1024 * FF; }
        const int nblk = N / 32, kb = r / nblk, nb = r % nblk, k0 = 64 * kb, n0 = 32 * nb;
        int drow = n0; float scale = 1.0f;
        if (mode == 1) drow = (n0 >> 7) * 256 + (n0 & 127);
        else if (mode == 2) drow = (n0 >> 7) * 256 + 128 + (n0 & 127);
        else if (mode == 3 && n0 < 512) scale = 0.08838834764831845f;
        transpose_item(W, K, N, WT, k0, n0, drow, scale, scr, lane);
    }
}

__device__ __forceinline__ void p0_prologue(const Args& a, ldsp lds, int tid, int lane, int wave) {
    unsigned char* ws = a.ws;
    LAS float* L = (LAS float*)lds;
    const int bx = blockIdx.x, G = gridDim.x;
    for (int job = bx; job < 192; job += G) {
        const float* c = a.in[3]; const float* c_ctx = a.in[4]; const float* ada_w = a.in[5]; const float* ada_b = a.in[6];
        float* mod = (float*)(ws + WS_MOD);
        for (int e = tid; e < NCOND * 1024; e += NTHREADS) { const int b = e >> 10, k = e & 1023; const float cv = (b == 0) ? c_ctx[k] : c[(b - 1) * 1024 + k]; L[e] = cv / (1.0f + __expf(-cv)); }
        __syncthreads();
        const int l = job / 96, n0 = (job % 96) * 64;
        const float* W = ada_w + ((size_t)l * 1024 + 128 * wave) * MODW + n0 + lane;
        float acc[NCOND];
#pragma unroll
        for (int b = 0; b < NCOND; ++b) acc[b] = 0.f;
        for (int kk = 0; kk < 128; kk += 32) {
            float w[32];
#pragma unroll
            for (int u = 0; u < 32; ++u) w[u] = W[(size_t)(kk + u) * MODW];
#pragma unroll
            for (int u = 0; u < 32; ++u)
#pragma unroll
                for (int b = 0; b < NCOND; ++b) acc[b] += L[b * 1024 + 128 * wave + kk + u] * w[u];
        }
        LAS float* red = L + NCOND * 1024;
#pragma unroll
        for (int b = 0; b < NCOND; ++b) red[(wave * NCOND + b) * 64 + lane] = acc[b];
        __syncthreads();
        for (int e = tid; e < NCOND * 64; e += NTHREADS) { const int b = e >> 6, ln = e & 63; float s = ada_b[l * MODW + n0 + ln];
#pragma unroll
            for (int w = 0; w < 8; ++w) s += red[(w * NCOND + b) * 64 + ln];
            mod[(size_t)(l * NCOND + b) * MODW + n0 + ln] = s; }
        __syncthreads();
    }
    if (bx == G - 1) {
        float* tab = (float*)(ws + WS_ROPE);
        for (int e = tid; e < 2048; e += NTHREADS) { const int pos = e >> 5, f = e & 31; const float fr = exp2f(-(float)f * (13.287712379549449f / 32.0f)); const float ang = (float)pos * fr;
            float rev = ang * 0.15915494309189535f; rev -= floorf(rev); tab[e] = __builtin_amdgcn_cosf(rev); tab[2048 + e] = __builtin_amdgcn_sinf(rev); }
    }
    convert_range(a, lds, 0, G == 256 ? CONV_EARLY : CONV_ALL, bx * NWAVES + wave, G * NWAVES, lane, wave);
}

template <bool FIRST>
__device__ __forceinline__ void norm_pass(const Args& a, const float* gn, const float* modl, int off_sh, int off_sc, bf16* outp, int lane, int wave) {
    const int gw = blockIdx.x * NWAVES + wave, NGW = gridDim.x * NWAVES;
    for (int m0 = gw; m0 < M; m0 += 2 * NGW) {
        const int m1 = m0 + NGW; const bool two = m1 < M;
        f32x4 v[2][4]; float s[2] = {0.f, 0.f};
#pragma unroll
        for (int q = 0; q < 2; ++q) { const int m = (q == 0 || two) ? (q == 0 ? m0 : m1) : m0;
            const float* xrow = FIRST ? (m < MCTX ? a.in[0] + (size_t)m * D : a.in[1] + (size_t)(m - MCTX) * D) : a.out + (size_t)m * D;
            const f32x4* xr = (const f32x4*)xrow + lane;
#pragma unroll
            for (int j = 0; j < 4; ++j) v[q][j] = FIRST ? __builtin_nontemporal_load(xr + 64 * j) : xr[64 * j]; }
#pragma unroll
        for (int q = 0; q < 2; ++q) {
#pragma unroll
            for (int j = 0; j < 4; ++j) s[q] += (v[q][j].x * v[q][j].x + v[q][j].y * v[q][j].y) + (v[q][j].z * v[q][j].z + v[q][j].w * v[q][j].w); }
#pragma unroll
        for (int q = 0; q < 2; ++q) { if (q == 1 && !two) break; const int m = q == 0 ? m0 : m1;
            const int cb = m < MCTX ? 0 : 1 + ((m - MCTX) >> 12);
            const float rstd = rsqrtf(wave_sum(s[q]) * (1.0f / D) + EPS);
            const float* mrow = modl + (size_t)cb * MODW;
#pragma unroll
            for (int j = 0; j < 4; ++j) { const int col = 4 * lane + 256 * j;
                const f32x4 g4 = *(const f32x4*)(gn + col), sc4 = *(const f32x4*)(mrow + off_sc + col), sh4 = *(const f32x4*)(mrow + off_sh + col);
                const f32x4 o = v[q][j] * rstd * g4 * (sc4 + 1.0f) + sh4;
                v2u w; w.x = pk2(o.x, o.y); w.y = pk2(o.z, o.w); *(v2u*)(outp + pg8::tiled_off(m, col, D)) = w; } }
    }
}
__device__ __forceinline__ void final_norm(const Args& a, const float* gn, int lane, int wave) {
    const int gw = blockIdx.x * NWAVES + wave, NGW = gridDim.x * NWAVES;
    for (int m = gw; m < M; m += NGW) {
        f32x4* xr = (f32x4*)(a.out + (size_t)m * D) + lane;
        f32x4 v[4]; float s = 0.f;
#pragma unroll
        for (int j = 0; j < 4; ++j) { v[j] = xr[64 * j]; s += (v[j].x * v[j].x + v[j].y * v[j].y) + (v[j].z * v[j].z + v[j].w * v[j].w); }
        const float rstd = rsqrtf(wave_sum(s) * (1.0f / D) + EPS);
#pragma unroll
        for (int j = 0; j < 4; ++j) { const f32x4 g4 = *(const f32x4*)(gn + 4 * lane + 256 * j); xr[64 * j] = v[j] * rstd * g4; }
    }
}

__device__ __forceinline__ void ld_tile(const bf16* src, int tid, v4u (&x)[2][2]) {
#pragma unroll
    for (int rep = 0; rep < 2; ++rep) { const int it = tid + rep * NTHREADS, tok = it >> 3, d0 = (it & 7) * 8;
        x[rep][0] = *(const v4u*)(src + (size_t)tok * NAB + d0); x[rep][1] = *(const v4u*)(src + (size_t)tok * NAB + 64 + d0); }
}
__device__ __forceinline__ void st_rope_tile(ldsp T, const v4u (&x)[2][2], bool rope, int tpos0, const float* tab, int tid) {
#pragma unroll
    for (int rep = 0; rep < 2; ++rep) { const int it = tid + rep * NTHREADS, tok = it >> 3, d0 = (it & 7) * 8;
        v4u x1 = x[rep][0], x2 = x[rep][1];
        if (rope) { const int tpos = tpos0 + tok, pos = d0 < 32 ? (tpos >> 6) : (tpos & 63), f0 = d0 & 31;
            const f32x4 c0 = *(const f32x4*)(tab + pos * 32 + f0), c1 = *(const f32x4*)(tab + pos * 32 + f0 + 4), s0 = *(const f32x4*)(tab + 2048 + pos * 32 + f0), s1 = *(const f32x4*)(tab + 2048 + pos * 32 + f0 + 4);
            const float cs[8] = {c0.x, c0.y, c0.z, c0.w, c1.x, c1.y, c1.z, c1.w}, sn[8] = {s0.x, s0.y, s0.z, s0.w, s1.x, s1.y, s1.z, s1.w};
            v4u o1, o2;
#pragma unroll
            for (int w = 0; w < 4; ++w) { const float a0 = bflo(x1[w]), a1 = bfhi(x1[w]), b0 = bflo(x2[w]), b1 = bfhi(x2[w]);
                o1[w] = pk2(a0 * cs[2 * w] - b0 * sn[2 * w], a1 * cs[2 * w + 1] - b1 * sn[2 * w + 1]);
                o2[w] = pk2(b0 * cs[2 * w] + a0 * sn[2 * w], b1 * cs[2 * w + 1] + a1 * sn[2 * w + 1]); }
            x1 = o1; x2 = o2; }
        *(LAS v4u*)(T + (tok * TS + d0) * 2) = x1; *(LAS v4u*)(T + (tok * TS + 64 + d0) * 2) = x2; }
}
__device__ __forceinline__ void ld_vtile(const bf16* src, int tid, v4u (&x)[4]) {
#pragma unroll
    for (int rep = 0; rep < 4; ++rep) { const int it = tid + rep * NTHREADS, tok = it >> 4, ch = it & 15; x[rep] = *(const v4u*)(src + (size_t)tok * NAB + ch * 8); }
}

__device__ __forceinline__ void r1_phase(const Args& a, ldsp lds, int tid0, int lane, int wave) {
    const bf16* P = (const bf16*)(a.ws + WS_P); bf16* UB = (bf16*)(a.ws + WS_YB); const float* tab = (const float*)(a.ws + WS_ROPE);
    const ldsp Kt = lds, Vf = lds + TILE_B, Vb = lds + 2 * TILE_B;
    const int r0 = lane & 15, kq0 = lane >> 4;
    v4u pk_[2][2], pv_[4];
    if ((int)blockIdx.x < 1280) { const int u = blockIdx.x; const bf16* Pg = P + (size_t)(u >> 2) * 128 * NAB; ld_tile(Pg + 512 + (u & 3) * 128, tid0, pk_); ld_vtile(Pg + 1024 + (u & 3) * 128, tid0, pv_); }
    for (int u = blockIdx.x; u < 1280; u += gridDim.x) {
        const int cidx = u >> 2, h = u & 3, row0 = cidx * 128; const bool lat = cidx >= 64; const int tpos0 = lat ? ((cidx - 64) & 31) * 128 : 0;
        const float l2f = log2_sigmoid(a.in[10][h]), l2b = log2_sigmoid(a.in[10][4 + h]);
        int tid = tid0, r = r0, kq = kq0; asm volatile("" : "+v"(tid), "+v"(r), "+v"(kq));
        __syncthreads();
        st_rope_tile(Kt, pk_, lat, tpos0, tab, tid);
#pragma unroll
        for (int rep = 0; rep < 4; ++rep) { const int it = tid + rep * NTHREADS, tok = it >> 4, ch = it & 15;
            const v4u x = pv_[rep];
            const float sf = __builtin_amdgcn_exp2f((float)(127 - tok) * l2f), sb = __builtin_amdgcn_exp2f((float)tok * l2b);
            v4u of, ob;
#pragma unroll
            for (int w = 0; w < 4; ++w) { const float lo = bflo(x[w]), hi = bfhi(x[w]); of[w] = pk2(lo * sf, hi * sf); ob[w] = pk2(lo * sb, hi * sb); }
            *(LAS v4u*)(Vf + (tok * TS + ch * 8) * 2) = of; *(LAS v4u*)(Vb + (tok * TS + ch * 8) * 2) = ob; }
        __syncthreads();
        { const int un = u + gridDim.x; if (un < 1280) { const bf16* Pn = P + (size_t)(un >> 2) * 128 * NAB; ld_tile(Pn + 512 + (un & 3) * 128, tid, pk_); ld_vtile(Pn + 1024 + (un & 3) * 128, tid, pv_); } }
        f32x4 acc[2][8];
#pragma unroll
        for (int d = 0; d < 2; ++d)
#pragma unroll
            for (int mt = 0; mt < 8; ++mt) acc[d][mt] = (f32x4){0.f, 0.f, 0.f, 0.f};
#pragma unroll
        for (int ks = 0; ks < 4; ++ks) { const int j0 = ks * 32 + kq * 8 + (r >> 2);
            const bf16x8 vfa = tr_frag(Vf + (j0 * TS + 16 * wave + 4 * (r & 3)) * 2, 8 * TS), vba = tr_frag(Vb + (j0 * TS + 16 * wave + 4 * (r & 3)) * 2, 8 * TS);
#pragma unroll
            for (int mt = 0; mt < 8; ++mt) { const bf16x8 ka = tr_frag(Kt + (j0 * TS + mt * 16 + 4 * (r & 3)) * 2, 8 * TS);
                acc[0][mt] = mfma16(ka, vfa, acc[0][mt]); acc[1][mt] = mfma16(ka, vba, acc[1][mt]); } }
#pragma unroll
        for (int d = 0; d < 2; ++d)
#pragma unroll
            for (int mt = 0; mt < 8; ++mt) { v2u w; w.x = pk2(acc[d][mt][0], acc[d][mt][1]); w.y = pk2(acc[d][mt][2], acc[d][mt][3]);
                *(v2u*)(UB + ((size_t)(u * 2 + d) * 128 + 16 * wave + r) * 128 + mt * 16 + 4 * kq) = w; }
    }
}

constexpr int SCAN_B = 8;
__device__ __forceinline__ void scan_item(const bf16* UB, bf16* SB, int cidx0, int n, int h, int dir, int e8, float dec, const float* S0, float* Sout) {
    const int dv = e8 >> 4, dk0 = (e8 & 15) * 8;
    float S[8];
#pragma unroll
    for (int i = 0; i < 8; ++i) S[i] = S0 ? S0[(size_t)(dk0 + i) * 128 + dv] : 0.f;
    for (int s0 = 0; s0 < n; s0 += SCAN_B) {
        v4u uu[SCAN_B]; size_t off[SCAN_B];
#pragma unroll
        for (int j = 0; j < SCAN_B; ++j) { const int st = s0 + j, c = dir == 0 ? st : n - 1 - st; off[j] = ((size_t)((cidx0 + c) * 4 + h) * 2 + dir) * 16384 + (size_t)e8 * 8;
            if (st < n) uu[j] = *(const v4u*)(UB + off[j]); else uu[j] = (v4u){0u, 0u, 0u, 0u}; }
#pragma unroll
        for (int j = 0; j < SCAN_B; ++j) { if (s0 + j < n) {
            v4u so; so.x = pk2(S[0], S[1]); so.y = pk2(S[2], S[3]); so.z = pk2(S[4], S[5]); so.w = pk2(S[6], S[7]);
            *(v4u*)(SB + off[j]) = so;
#pragma unroll
            for (int w = 0; w < 4; ++w) { S[2 * w] = dec * S[2 * w] + bflo(uu[j][w]); S[2 * w + 1] = dec * S[2 * w + 1] + bfhi(uu[j][w]); } } }
    }
    if (Sout) {
#pragma unroll
        for (int i = 0; i < 8; ++i) __builtin_nontemporal_store(S[i], Sout + (size_t)(dk0 + i) * 128 + dv); }
}
__device__ __forceinline__ void r2_phase(const Args& a, int tid) {
    const bf16* UB = (const bf16*)(a.ws + WS_YB); bf16* SB = (bf16*)(a.ws + WS_HB);
    const int NT = gridDim.x * NTHREADS;
    for (int t = blockIdx.x * NTHREADS + tid; t < 131072; t += NT) {
        const int e8 = t & 2047, dir = (t >> 11) & 1, h = (t >> 12) & 3, s = t >> 14;
        const float dec = exp2f(128.0f * log2_sigmoid(a.in[10][dir * 4 + h]));
        scan_item(UB, SB, 64 + s * 32, 32, h, dir, e8, dec, a.in[2] + (size_t)((s * 2 + dir) * 4 + h) * 16384, nullptr);
    }
    for (int t = blockIdx.x * NTHREADS + tid; t < 524288; t += NT) {
        const int e8 = t & 2047, dir = (t >> 11) & 1, h = (t >> 12) & 3, s = t >> 14;
        const float dec = exp2f(128.0f * log2_sigmoid(a.in[10][dir * 4 + h]));
        scan_item(UB, SB, s * 2, 2, h, dir, e8, dec, nullptr, a.out + (size_t)M * D + (size_t)((s * 2 + dir) * 4 + h) * 16384);
    }
}

__device__ __forceinline__ void r3_phase(const Args& a, ldsp lds, int tid0, int lane, int wave) {
    const bf16* P = (const bf16*)(a.ws + WS_P); const bf16* SB = (const bf16*)(a.ws + WS_HB); bf16* YB = (bf16*)(a.ws + WS_YB); const float* tab = (const float*)(a.ws + WS_ROPE);
    const ldsp Qt = lds, Kt = lds + TILE_B, Vt = lds + 2 * TILE_B, Pt = lds + 3 * TILE_B;
    const int r0 = lane & 15, kq0 = lane >> 4;
#ifndef NO_RET
    v4u pq_[2][2], pk_[2][2], pv_[4];
    v4u pg_[4];
    if ((int)blockIdx.x < 1280) { const int u = blockIdx.x, ln = tid0 & 63; const bf16* gp = P + (size_t)((u >> 2) * 128 + 16 * wave + (ln >> 2)) * NAB + 1536 + (u & 3) * 128 + (ln & 3) * 32;
#pragma unroll
        for (int k = 0; k < 4; ++k) pg_[k] = *(const v4u*)(gp + k * 8); }
    if ((int)blockIdx.x < 1280) { const int u = blockIdx.x; const bf16* Pg0 = P + (size_t)(u >> 2) * 128 * NAB; ld_tile(Pg0 + (u & 3) * 128, tid0, pq_); ld_tile(Pg0 + 512 + (u & 3) * 128, tid0, pk_); ld_vtile(Pg0 + 1024 + (u & 3) * 128, tid0, pv_); }
    for (int u = blockIdx.x; u < 1280; u += gridDim.x) {
        const int cidx = u >> 2, h = u & 3, row0 = cidx * 128; const bool lat = cidx >= 64; const int tpos0 = lat ? ((cidx - 64) & 31) * 128 : 0;
        const float l2f = log2_sigmoid(a.in[10][h]), l2b = log2_sigmoid(a.in[10][4 + h]);
        const bf16* Pg = P + (size_t)row0 * NAB;
        int tid = tid0, r = r0, kq = kq0; asm volatile("" : "+v"(tid), "+v"(r), "+v"(kq));
        __syncthreads();
        st_rope_tile(Qt, pq_, lat, tpos0, tab, tid);
        st_rope_tile(Kt, pk_, lat, tpos0, tab, tid);
#pragma unroll
        for (int rep = 0; rep < 4; ++rep) { const int it = tid + rep * NTHREADS, tok = it >> 4, ch = it & 15; *(LAS v4u*)(Vt + (tok * TS + ch * 8) * 2) = pv_[rep]; }
        __syncthreads();
        { const int un = u + gridDim.x; if (un < 1280) { const bf16* Pn = P + (size_t)(un >> 2) * 128 * NAB; ld_tile(Pn + (un & 3) * 128, tid, pq_); ld_tile(Pn + 512 + (un & 3) * 128, tid, pk_); ld_vtile(Pn + 1024 + (un & 3) * 128, tid, pv_); } }
        const int il = 16 * wave + r;
        int ilq = il - 4 * kq; asm volatile("" : "+v"(ilq));
        bf16x8 qf[4];
#pragma unroll
        for (int ks = 0; ks < 4; ++ks) qf[ks] = *(const LAS bf16x8*)(Qt + (il * TS + ks * 32 + kq * 8) * 2);
#pragma unroll
        for (int nt = 0; nt < 8; ++nt) { f32x4 c = (f32x4){0.f, 0.f, 0.f, 0.f};
#pragma unroll
            for (int ks = 0; ks < 4; ++ks) { const bf16x8 kf = *(const LAS bf16x8*)(Kt + ((nt * 16 + r) * TS + ks * 32 + kq * 8) * 2); c = mfma16(kf, qf[ks], c); }
            float p[4];
#pragma unroll
            for (int e = 0; e < 4; ++e) { const float fd = (float)(ilq - (nt * 16 + e));
                const float dm = (fd == 0.0f) ? 2.0f : __builtin_amdgcn_exp2f(fmaxf(fd, 0.0f) * l2f + fmaxf(-fd, 0.0f) * l2b); p[e] = c[e] * dm; }
            v2u w; w.x = pk2(p[0], p[1]); w.y = pk2(p[2], p[3]);
            *(LAS v2u*)(Pt + (il * TS + nt * 16 + 4 * kq) * 2) = w; asm volatile("" ::: "memory"); }
        asm volatile("s_waitcnt lgkmcnt(0)" ::: "memory");
        __syncthreads();
        v4u sreg[4];
        { const bf16* Sg = SB + (size_t)(u * 2) * 16384;
#pragma unroll
          for (int rep = 0; rep < 4; ++rep) { const int it = tid + rep * NTHREADS; sreg[rep] = *(const v4u*)(Sg + (it >> 4) * 128 + (it & 15) * 8); } }
        f32x4 oi[8];
#pragma unroll
        for (int nt = 0; nt < 8; ++nt) oi[nt] = (f32x4){0.f, 0.f, 0.f, 0.f};
#pragma unroll
        for (int ks = 0; ks < 4; ++ks) { const bf16x8 pf = *(const LAS bf16x8*)(Pt + (il * TS + ks * 32 + kq * 8) * 2); const int j0 = ks * 32 + kq * 8 + (r >> 2);
#pragma unroll
            for (int nt = 0; nt < 8; ++nt) { const bf16x8 vf = tr_frag(Vt + (j0 * TS + nt * 16 + 4 * (r & 3)) * 2, 8 * TS); oi[nt] = mfma16(pf, vf, oi[nt]); }
            asm volatile("" ::: "memory"); }
#pragma unroll
        for (int rep = 0; rep < 4; ++rep) { const int it = tid + rep * NTHREADS; *(LAS v4u*)(Kt + ((it >> 4) * TS + (it & 15) * 8) * 2) = sreg[rep]; }
        __syncthreads();
        { const bf16* Sg = SB + (size_t)(u * 2 + 1) * 16384;
#pragma unroll
          for (int rep = 0; rep < 4; ++rep) { const int it = tid + rep * NTHREADS; sreg[rep] = *(const v4u*)(Sg + (it >> 4) * 128 + (it & 15) * 8); } }
        int iq = 16 * wave + 4 * kq; asm volatile("" : "+v"(iq));
#pragma unroll
        for (int dir = 0; dir < 2; ++dir) {
            const ldsp St = dir == 0 ? Kt : Vt;
            if (dir == 1) {
#pragma unroll
                for (int rep = 0; rep < 4; ++rep) { const int it = tid + rep * NTHREADS; *(LAS v4u*)(Vt + ((it >> 4) * TS + (it & 15) * 8) * 2) = sreg[rep]; }
                __syncthreads();
            }
            float cr[4];
#pragma unroll
            for (int e = 0; e < 4; ++e) cr[e] = dir == 0 ? __builtin_amdgcn_exp2f((float)(iq + e + 1) * l2f) : __builtin_amdgcn_exp2f((float)(128 - iq - e) * l2b);
#pragma unroll
            for (int nt = 0; nt < 8; ++nt) {
                f32x4 t = (f32x4){0.f, 0.f, 0.f, 0.f};
#pragma unroll
                for (int ks = 0; ks < 4; ++ks) { const bf16x8 sf = *(const LAS bf16x8*)(St + ((nt * 16 + r) * TS + ks * 32 + kq * 8) * 2); t = mfma16(qf[ks], sf, t); }
#pragma unroll
                for (int e = 0; e < 4; ++e) oi[nt][e] += cr[e] * t[e];
                asm volatile("" ::: "memory");
            }
        }
        float ss[4];
#pragma unroll
        for (int e = 0; e < 4; ++e) { float s = 0.f;
#pragma unroll
            for (int nt = 0; nt < 8; ++nt) s += oi[nt][e] * oi[nt][e];
            s += __shfl_xor(s, 1); s += __shfl_xor(s, 2); s += __shfl_xor(s, 4); s += __shfl_xor(s, 8);
            ss[e] = rsqrtf(s * (1.0f / 128.0f) + EPS); }
#pragma unroll
        for (int nt = 0; nt < 8; ++nt)
#pragma unroll
            for (int e = 0; e < 4; ++e) *(LAS bf16*)(Pt + ((16 * wave + 4 * kq + e) * TS + nt * 16 + r) * 2) = (bf16)(pk2(oi[nt][e] * ss[e], 0.f) & 0xffffu);
        asm volatile("s_waitcnt lgkmcnt(0)" ::: "memory");
        { const int ln = kq * 16 + r, rw = ln >> 2, c4 = ln & 3, lrow = 16 * wave + rw; const float* rg = a.in[11] + h * 128 + c4 * 32;
#pragma unroll
            for (int k = 0; k < 4; ++k) { const v4u o8 = *(const LAS v4u*)(Pt + (lrow * TS + c4 * 32 + k * 8) * 2); const v4u g8 = pg_[k];
                const f32x4 r0 = *(const f32x4*)(rg + k * 8), r1 = *(const f32x4*)(rg + k * 8 + 4); const float rgv[8] = {r0.x, r0.y, r0.z, r0.w, r1.x, r1.y, r1.z, r1.w};
                v4u y;
#pragma unroll
                for (int w = 0; w < 4; ++w) { const float g0 = bflo(g8[w]), g1 = bfhi(g8[w]);
                    y[w] = pk2(g0 * pg8::fast_sigmoid(g0) * bflo(o8[w]) * rgv[2 * w], g1 * pg8::fast_sigmoid(g1) * bfhi(o8[w]) * rgv[2 * w + 1]); }
                *(v4u*)(YB + pg8::tiled_off(row0 + lrow, h * 128 + c4 * 32 + k * 8, D)) = y; }
            const int un = u + gridDim.x; if (un < 1280) { const bf16* gp = P + (size_t)((un >> 2) * 128 + lrow) * NAB + 1536 + (un & 3) * 128 + c4 * 32;
#pragma unroll
                for (int k = 0; k < 4; ++k) pg_[k] = *(const v4u*)(gp + k * 8); } }
    }
#endif
#ifndef NO_CONV
    {
        const float* cw = a.in[12]; const float* cbv = a.in[13];
        const int NT = gridDim.x * NTHREADS, gt = blockIdx.x * NTHREADS + tid0, c0 = (gt & 63) * 8;
        float w0[8], w1[8], w2[8], bb[8];
#pragma unroll
        for (int q = 0; q < 2; ++q) { const f32x4 t0 = *(const f32x4*)(cw + c0 + 4 * q), t1 = *(const f32x4*)(cw + 512 + c0 + 4 * q), t2 = *(const f32x4*)(cw + 1024 + c0 + 4 * q), t3 = *(const f32x4*)(cbv + c0 + 4 * q);
#pragma unroll
            for (int j = 0; j < 4; ++j) { w0[4 * q + j] = t0[j]; w1[4 * q + j] = t1[j]; w2[4 * q + j] = t2[j]; bb[4 * q + j] = t3[j]; } }
        for (int it = gt; it < (M / 4) * 64; it += NT) {
            const int m0 = (it >> 6) * 4;
            const int slen = m0 < MCTX ? 256 : 4096, pos0 = m0 < MCTX ? (m0 & 255) : ((m0 - MCTX) & 4095);
            const bf16* Pm = P + (size_t)m0 * NAB;
            v4u cg[6], xc[6], bg[4];
#pragma unroll
            for (int q = 0; q < 6; ++q) { const bool ok = (q == 0) ? (pos0 > 0) : ((q == 5) ? (pos0 + 4 < slen) : true);
                if (ok) { cg[q] = *(const v4u*)(Pm + (ptrdiff_t)(q - 1) * NAB + 2560 + c0); xc[q] = *(const v4u*)(Pm + (ptrdiff_t)(q - 1) * NAB + 3072 + c0); } else { cg[q] = (v4u){0u, 0u, 0u, 0u}; xc[q] = cg[q]; } }
#pragma unroll
            for (int q = 0; q < 4; ++q) bg[q] = *(const v4u*)(Pm + (size_t)q * NAB + 2048 + c0);
            float z[6][8];
#pragma unroll
            for (int q = 0; q < 6; ++q)
#pragma unroll
                for (int w = 0; w < 4; ++w) { z[q][2 * w] = bflo(cg[q][w]) * bflo(xc[q][w]); z[q][2 * w + 1] = bfhi(cg[q][w]) * bfhi(xc[q][w]); }
#pragma unroll
            for (int q = 0; q < 4; ++q) { v4u y;
#pragma unroll
                for (int w = 0; w < 4; ++w) {
                    const float y0 = bflo(bg[q][w]) * (w0[2 * w] * z[q][2 * w] + w1[2 * w] * z[q + 1][2 * w] + w2[2 * w] * z[q + 2][2 * w] + bb[2 * w]);
                    const float y1 = bfhi(bg[q][w]) * (w0[2 * w + 1] * z[q][2 * w + 1] + w1[2 * w + 1] * z[q + 1][2 * w + 1] + w2[2 * w + 1] * z[q + 2][2 * w + 1] + bb[2 * w + 1]);
                    y[w] = pk2(y0, y1); }
                *(v4u*)(YB + pg8::tiled_off(m0 + q, 512 + c0, D)) = y; }
        }
    }
#endif
}

__device__ __forceinline__ void spatial_phase(const Args& a, ldsp lds, int tid0, int lane, int wave) {
    const bf16* Z = (const bf16*)(a.ws + WS_P); bf16* YB = (bf16*)(a.ws + WS_YB); const float* vsq = (const float*)(a.ws + WS_VSQ);
    const float* w_s = a.in[17]; const float* b_s = a.in[18]; const float* vg = a.in[16];
    const ldsp At = lds, Vt = lds + TILE_B; LAS float* rs = (LAS float*)(lds + TILE_B + 128 * VS * 2);
    const int r0 = lane & 15, kq0 = lane >> 4;
    for (int u = blockIdx.x; u < 1280; u += gridDim.x) {
        const int cidx = u >> 2, g = u & 3, row0 = cidx * 128;
        int tid = tid0, r = r0, kq = kq0; asm volatile("" : "+v"(tid), "+v"(r), "+v"(kq));
        __syncthreads();
        if (tid < 128) { const f32x4* vp = (const f32x4*)(vsq + (size_t)(row0 + tid) * 16); const f32x4 s0 = vp[0], s1 = vp[1], s2 = vp[2], s3 = vp[3];
            const float s = ((s0.x + s0.y) + (s0.z + s0.w)) + ((s1.x + s1.y) + (s1.z + s1.w)) + ((s2.x + s2.y) + (s2.z + s2.w)) + ((s3.x + s3.y) + (s3.z + s3.w));
            rs[tid] = rsqrtf(s * (1.0f / 1024.0f) + EPS); }
#pragma unroll
        for (int rep = 0; rep < 8; ++rep) { const int it = tid + rep * NTHREADS, q = it >> 5, c = it & 31;
            *(LAS v4u*)(Vt + (q * VS + c * 8) * 2) = *(const v4u*)(Z + (size_t)(row0 + q) * NC + 1024 + g * 256 + c * 8); }
        __syncthreads();
#pragma unroll
        for (int rep = 0; rep < 4; ++rep) { const int it = tid + rep * NTHREADS, p = it >> 4, c = it & 15;
            const f32x4 w0 = *(const f32x4*)(w_s + (size_t)(g * 128 + p) * 128 + c * 8), w1 = *(const f32x4*)(w_s + (size_t)(g * 128 + p) * 128 + c * 8 + 4);
            const LAS float* rq = rs + c * 8;
            v4u o; o.x = pk2(w0.x * rq[0], w0.y * rq[1]); o.y = pk2(w0.z * rq[2], w0.w * rq[3]); o.z = pk2(w1.x * rq[4], w1.y * rq[5]); o.w = pk2(w1.z * rq[6], w1.w * rq[7]);
            *(LAS v4u*)(At + (p * TS + c * 8) * 2) = o; }
        __syncthreads();
        f32x4 acc[2][8];
#pragma unroll
        for (int n2 = 0; n2 < 2; ++n2)
#pragma unroll
            for (int mt = 0; mt < 8; ++mt) acc[n2][mt] = (f32x4){0.f, 0.f, 0.f, 0.f};
#pragma unroll
        for (int ks = 0; ks < 4; ++ks) { const int q0 = ks * 32 + kq * 8 + (r >> 2);
            const bf16x8 va0 = tr_frag(Vt + (q0 * VS + 32 * wave + 4 * (r & 3)) * 2, 8 * VS), va1 = tr_frag(Vt + (q0 * VS + 32 * wave + 16 + 4 * (r & 3)) * 2, 8 * VS);
#pragma unroll
            for (int mt = 0; mt < 8; ++mt) { const bf16x8 wf = *(const LAS bf16x8*)(At + ((mt * 16 + r) * TS + ks * 32 + kq * 8) * 2);
                acc[0][mt] = mfma16(va0, wf, acc[0][mt]); acc[1][mt] = mfma16(va1, wf, acc[1][mt]); } }
#pragma unroll
        for (int n2 = 0; n2 < 2; ++n2) { const int gch = g * 256 + 32 * wave + 16 * n2 + 4 * kq; const f32x4 vg4 = *(const f32x4*)(vg + gch);
#pragma unroll
            for (int mt = 0; mt < 8; ++mt) { const int p = mt * 16 + r; const float bsp = b_s[g * 128 + p];
                const v2u uu = *(const v2u*)(Z + (size_t)(row0 + p) * NC + gch);
                const float s0 = acc[n2][mt][0] * vg4.x + bsp, s1 = acc[n2][mt][1] * vg4.y + bsp, s2 = acc[n2][mt][2] * vg4.z + bsp, s3 = acc[n2][mt][3] * vg4.w + bsp;
                v2u y; y.x = pk2(bflo(uu.x) * s0, bfhi(uu.x) * s1); y.y = pk2(bflo(uu.y) * s2, bfhi(uu.y) * s3);
                *(v2u*)(YB + pg8::tiled_off(row0 + p, gch, D)) = y; } }
    }
}

__device__ __forceinline__ void shw_phase(const Args& a, int lane, int rw_lo, int rw_hi, int gw, int NGW) {
    unsigned char* ws = a.ws; const float* mod0 = (const float*)(ws + WS_MOD); const float* mod1 = mod0 + NCOND * MODW; float* shw = (float*)(ws + WS_SHW);
    for (int rw = rw_lo + gw; rw < rw_hi; rw += NGW) {
        const bf16* wrow; const float* sh; float* dst; int nb, n;
        if (rw < NGU) { n = rw; wrow = (const bf16*)(ws + WS_WGU); sh = mod0 + 3072; dst = shw; nb = NGU; }
        else if (rw < NGU + NC) { n = rw - NGU; wrow = (const bf16*)(ws + WS_WINC); sh = mod1; dst = shw + NCOND * NGU; nb = NC; }
        else { n = rw - NGU - NC; wrow = (const bf16*)(ws + WS_WGU) + (size_t)NGU * 1024; sh = mod1 + 3072; dst = shw + NCOND * (NGU + NC); nb = NGU; }
        const v4u w0 = *(const v4u*)(wrow + pg8::tiled_off_b(n, lane * 16, 1024)), w1 = *(const v4u*)(wrow + pg8::tiled_off_b(n, lane * 16 + 8, 1024));
        float wf[16];
#pragma unroll
        for (int q = 0; q < 4; ++q) { wf[2 * q] = bflo(w0[q]); wf[2 * q + 1] = bfhi(w0[q]); wf[8 + 2 * q] = bflo(w1[q]); wf[8 + 2 * q + 1] = bfhi(w1[q]); }
#pragma unroll
        for (int cb = 0; cb < NCOND; ++cb) { const f32x4* sp = (const f32x4*)(sh + (size_t)cb * MODW + lane * 16); float s = 0.f;
#pragma unroll
            for (int q = 0; q < 4; ++q) { const f32x4 t = sp[q]; s += (t.x * wf[4 * q] + t.y * wf[4 * q + 1]) + (t.z * wf[4 * q + 2] + t.w * wf[4 * q + 3]); }
            s = wave_sum(s); if (lane == 0) dst[(size_t)cb * nb + n] = s; }
    }
}

__device__ __forceinline__ void fn_row(const v4u x0, const v4u x1, float* yrow, const float* gn, int lane) {
    float v[16];
#pragma unroll
    for (int q = 0; q < 4; ++q) { v[2 * q] = bflo(x0[q]); v[2 * q + 1] = bfhi(x0[q]); v[8 + 2 * q] = bflo(x1[q]); v[8 + 2 * q + 1] = bfhi(x1[q]); }
    float s = 0.f;
#pragma unroll
    for (int q = 0; q < 16; ++q) s += v[q] * v[q];
    const float rstd = rsqrtf(wave_sum(s) * (1.0f / D) + EPS);
#pragma unroll
    for (int c = 0; c < 2; ++c) { const int col = 8 * lane + 512 * c; const f32x4 g0 = *(const f32x4*)(gn + col), g1 = *(const f32x4*)(gn + col + 4);
        __builtin_nontemporal_store((f32x4){v[8 * c] * rstd * g0.x, v[8 * c + 1] * rstd * g0.y, v[8 * c + 2] * rstd * g0.z, v[8 * c + 3] * rstd * g0.w}, (f32x4*)(yrow + col));
        __builtin_nontemporal_store((f32x4){v[8 * c + 4] * rstd * g1.x, v[8 * c + 5] * rstd * g1.y, v[8 * c + 6] * rstd * g1.z, v[8 * c + 7] * rstd * g1.w}, (f32x4*)(yrow + col + 4)); }
}
__device__ __forceinline__ void final_norm_direct(const bf16* src, int src_row0, float* y, const float* gn, int m_lo, int m_hi, int lane, int wave) {
    const int gw = blockIdx.x * NWAVES + wave, NGW = gridDim.x * NWAVES;
    for (int m = m_lo + gw; m < m_hi; m += 2 * NGW) { const int mb = m + NGW; const bool two = mb < m_hi;
        const bf16* xr = src + (size_t)(m - src_row0) * D + 8 * lane; const bf16* xs = src + (size_t)((two ? mb : m) - src_row0) * D + 8 * lane;
        const v4u x0 = *(const v4u*)xr, x1 = *(const v4u*)(xr + 512), z0 = *(const v4u*)xs, z1 = *(const v4u*)(xs + 512);
        fn_row(x0, x1, y + (size_t)m * D, gn, lane); if (two) fn_row(z0, z1, y + (size_t)mb * D, gn, lane); }
}
constexpr int FN_SPLIT = M / 2;
#define XB_TMO      128
#define XB_XCNT(j)  (256  + 64 * (j))
#define XB_XSUB(j)  (1280 + 64 * (j))
#define XB_XGEN(j)  (2304 + 64 * (j))
#define XB_TOP      3328
#define XB_TOPGEN   3392
#define XCD_BAR_WORDS 3456
#define XB_SPIN_CAP (1u << 18)

__device__ __forceinline__ unsigned xb_ld(unsigned* p)              { return __hip_atomic_load(p, __ATOMIC_RELAXED, __HIP_MEMORY_SCOPE_AGENT); }
__device__ __forceinline__ unsigned xb_add(unsigned* p, unsigned v) { return __hip_atomic_fetch_add(p, v, __ATOMIC_RELAXED, __HIP_MEMORY_SCOPE_AGENT); }
__device__ __forceinline__ unsigned xb_xcc_id() { return (unsigned)__builtin_amdgcn_s_getreg((3 << 11) | 20) & 0xFu; }
#define XB_SPIN(cond, bar) do { unsigned _sp = 0; while (cond) { __builtin_amdgcn_s_sleep(1); \
    if ((++_sp & 255u) == 0u) { if (xb_ld(&(bar)[XB_TMO])) break; if (_sp > XB_SPIN_CAP) { atomicAdd(&(bar)[XB_TMO], 1u); break; } } } } while (0)

struct XcdBarrier {
    unsigned* bar; unsigned x;
    volatile LAS unsigned* st;
};

__device__ __forceinline__ XcdBarrier xcd_barrier_post(unsigned* bar, volatile LAS unsigned* st) {
    XcdBarrier b; b.bar = bar; b.x = xb_xcc_id(); b.st = st;
    if (threadIdx.x == 0) (void)xb_add(&bar[XB_XCNT(b.x)], 1u);
    return b;
}
__device__ __forceinline__ void xcd_barrier_complete(unsigned* bar, unsigned x, unsigned& nloc, unsigned& nx) {
    const unsigned G = gridDim.x * gridDim.y * gridDim.z;
    unsigned sum, cnt, mine, sp = 0u;
    for (;;) {
        sum = 0u; cnt = 0u; mine = 0u;
#pragma unroll
        for (unsigned j = 0; j < 16; ++j) { const unsigned c = xb_ld(&bar[XB_XCNT(j)]); sum += c; cnt += (c > 0u) ? 1u : 0u; mine = (j == x) ? c : mine; }
        if (sum == G) break;
        __builtin_amdgcn_s_sleep(1);
        if ((++sp & 255u) == 0u) { if (xb_ld(&bar[XB_TMO])) break; if (sp > XB_SPIN_CAP) { atomicAdd(&bar[XB_TMO], 1u); break; } }
    }
    nloc = mine > 0u ? mine : 1u; nx = cnt > 0u ? cnt : 1u;
}

__device__ __forceinline__ void xcd_barrier(const XcdBarrier& b) {
    asm volatile("s_waitcnt vmcnt(0)" ::: "memory");
    __syncthreads();
    if (threadIdx.x == 0) {
        unsigned* bar = b.bar;
        __builtin_amdgcn_s_waitcnt(0);
        unsigned nloc = b.st[0], nx = b.st[1];
        if (nloc == 0u) { xcd_barrier_complete(bar, b.x, nloc, nx); b.st[0] = nloc; b.st[1] = nx; }
        const unsigned old = xb_add(&bar[XB_XSUB(b.x)], 1u);
        const unsigned gen = old / nloc;
        if (old + 1u == (gen + 1u) * nloc) {
            __builtin_amdgcn_fence(__ATOMIC_RELEASE, "agent");
            asm volatile("s_waitcnt vmcnt(0)" ::: "memory");
            const unsigned og = xb_add(&bar[XB_TOP], 1u);
            const unsigned tg = og / nx;
            if (og + 1u == (tg + 1u) * nx) xb_add(&bar[XB_TOPGEN], 1u);
            else XB_SPIN(xb_ld(&bar[XB_TOPGEN]) == tg, bar);
            __builtin_amdgcn_fence(__ATOMIC_ACQUIRE, "agent");
            xb_add(&bar[XB_XGEN(b.x)], 1u);
            asm volatile("s_waitcnt vmcnt(0)" ::: "memory");
        } else {
            XB_SPIN(xb_ld(&bar[XB_XGEN(b.x)]) == gen, bar);
            __builtin_amdgcn_fence(__ATOMIC_ACQUIRE, "agent");
            asm volatile("s_waitcnt vmcnt(0)" ::: "memory");
        }
    }
    __syncthreads();
}

__global__ void __launch_bounds__(NTHREADS, 2) mega_fwd(Args a) {
    extern __shared__ __attribute__((aligned(16))) unsigned char lds_raw[];
    const ldsp lds = (ldsp)lds_raw;
    const int tid = threadIdx.x, lane = tid & 63, wave = __builtin_amdgcn_readfirstlane(tid >> 6);
    unsigned char* ws = a.ws;
    float* mod0 = (float*)(ws + WS_MOD); float* mod1 = mod0 + NCOND * MODW;
    bf16* HB = (bf16*)(ws + WS_HB); bf16* YB = (bf16*)(ws + WS_YB); bf16* PB = (bf16*)(ws + WS_P);
    const int G = gridDim.x, bx = blockIdx.x;
#if ONE_LAUNCH
    volatile LAS unsigned* misc = (volatile LAS unsigned*)(lds + MISC_OFF);
    if (tid < 16) misc[tid] = 0u;
    __syncthreads();
    const XcdBarrier xbar = xcd_barrier_post((unsigned*)(ws + WS_BAR), misc);
#endif
#define IN(k) (((PH_MASK >> (k)) & 1) && a.ph_lo <= (k) && (k) < a.ph_hi)
#define INN(k) (a.ph_lo <= (k) && (k) < a.ph_hi)
#if ONE_LAUNCH
#define SEAM(k) do { if (INN(k) && INN((k) + 1)) xcd_barrier(xbar); } while (0)
#else
#define SEAM(k) do { } while (0)
#endif
#define STAGGER(ticks) do { if (ONE_LAUNCH && (ticks) > 0) { const unsigned long long t0_ = __builtin_amdgcn_s_memrealtime(); const unsigned long long dl_ = (unsigned long long)(((bx >> 3) & 31) * (ticks)) >> 5; \
        while (__builtin_amdgcn_s_memrealtime() - t0_ < dl_) __builtin_amdgcn_s_sleep(16); } } while (0)
#define GEMM(EpiT, Aop, Bop, Nn, Kk, Eobj) do { pg8::Gemm g_{(const pg8::bf16_t*)(Aop), (const pg8::bf16_t*)(Bop), M, (Nn), (Kk)}; pg8::StaticOrder S_; S_.init(M, (Nn), G, bx); \
        pg8::gemm_phase<EpiT, pg8::StaticOrder, true, true>(lds, g_, S_, (Eobj)); } while (0)

#if ONE_LAUNCH
    if (a.ph_lo < 0) cg::this_grid().sync();
#endif
    if (IN(0)) p0_prologue(a, lds, tid, lane, wave);
    SEAM(0);
    if (IN(1)) { norm_pass<true>(a, a.in[7], mod0, 0, 1024, HB, lane, wave); shw_phase(a, lane, 0, G == 256 ? NGU : 2 * NGU + NC, bx * NWAVES + wave, G * NWAVES); }
    SEAM(1);
    if (IN(2)) { pg8::EpiStoreBf16 E{PB, NAB}; GEMM(pg8::EpiStoreBf16, HB, ws + WS_WAB, NAB, 1024, E); }
    SEAM(2);
    if (IN(3)) r1_phase(a, lds, tid, lane, wave);
    SEAM(3);
    if (IN(4)) r2_phase(a, tid);
    SEAM(4);
    if (IN(5)) r3_phase(a, lds, tid, lane, wave);
    SEAM(5);
    float* rsq = (float*)(ws + WS_RSQ); const float* shw = (const float*)(ws + WS_SHW);
    bf16* XB0 = (bf16*)a.out; bf16* XB1 = XB0 + (size_t)M * D;
    typedef pg8::EpiResidB<true, true> EpiR0; typedef pg8::EpiResidB<false, true> EpiR1; typedef pg8::EpiResidB<false, false> EpiR2;
    if (IN(6)) { EpiR0 E{a.in[0], a.in[1], nullptr, XB0, mod0 + 2048, HB, a.in[8], mod0 + 4096, rsq}; GEMM(EpiR0, YB, ws + WS_WOAB, 1024, 1024, E);
        if (G == 256 && bx >= 128) convert_range(a, lds, CONV_EARLY, CONV_ALL, (bx - 128) * NWAVES + wave, 128 * NWAVES, lane, wave); }
    SEAM(6);
    if (IN(8)) { pg8::EpiSwiglu E{PB, FF, rsq, shw, NGU}; GEMM(pg8::EpiSwiglu, HB, ws + WS_WGU, NGU, 1024, E); }
    SEAM(8);
    if (IN(9)) { EpiR1 E{nullptr, nullptr, XB0, XB1, mod0 + 5120, HB, a.in[7] + D, mod1 + 1024, rsq}; GEMM(EpiR1, PB, ws + WS_WDN, 1024, FF, E);
        if (G == 256 && bx >= 128) shw_phase(a, lane, NGU, 2 * NGU + NC, (bx - 128) * NWAVES + wave, 128 * NWAVES); }
    SEAM(9);
    if (IN(11)) { pg8::EpiGeluSq E{PB, NC, (float*)(ws + WS_VSQ), 4, rsq, shw + NCOND * NGU, NC}; GEMM(pg8::EpiGeluSq, HB, ws + WS_WINC, NC, 1024, E); }
    SEAM(11);
    if (IN(12)) spatial_phase(a, lds, tid, lane, wave);
    SEAM(12);
    if (IN(13)) { EpiR1 E{nullptr, nullptr, XB1, XB0, mod1 + 2048, HB, a.in[8] + D, mod1 + 4096, rsq}; GEMM(EpiR1, YB, ws + WS_WOC, 1024, 1024, E); }
    SEAM(13);
    if (IN(15)) { pg8::EpiSwiglu E{PB, FF, rsq, shw + NCOND * (NGU + NC), NGU}; GEMM(pg8::EpiSwiglu, HB, ws + WS_WGU + (size_t)NGU * 1024 * 2, NGU, 1024, E); }
    SEAM(15);
    if (IN(16)) { EpiR2 E{nullptr, nullptr, XB0, HB, mod1 + 5120, nullptr, nullptr, nullptr, nullptr};
    GEMM(EpiR2, PB, ws + WS_WDN + (size_t)1024 * FF * 2, 1024, FF, E); }
    SEAM(16);
    if (IN(17)) final_norm_direct(HB, 0, a.out, a.in[23], 0, M, lane, wave);
#undef IN
#undef STAGGER
#undef SEAM
#undef GEMM
}

extern "C" void kernel_launch(void* const* d_in, const int* in_sizes, int n_in, void* d_out, int out_size, void* d_ws, size_t ws_size, hipStream_t stream) {
    static int grid = 0;
    if (grid == 0) {
        if (n_in != 24 || ws_size < WS_END) { fprintf(stderr, "kernel_launch: unexpected n_in %d / ws_size %zu\n", n_in, ws_size); grid = -1; return; }
        int dev = 0, cus = 0;
        if (hipGetDevice(&dev) != hipSuccess || hipDeviceGetAttribute(&cus, hipDeviceAttributeMultiprocessorCount, dev) != hipSuccess) { grid = -1; return; }
        if (hipFuncSetAttribute((const void*)mega_fwd, hipFuncAttributeMaxDynamicSharedMemorySize, LDS_BYTES) != hipSuccess) { fprintf(stderr, "kernel_launch: hipFuncSetAttribute failed\n"); grid = -1; return; }
        (void)hipGetLastError();
        grid = cus;
    }
    if (grid < 0) return;
    Args a{};
    for (int i = 0; i < 24; ++i) a.in[i] = (const float*)d_in[i];
    a.out = (float*)d_out; a.ws = (unsigned char*)d_ws;
#if ONE_LAUNCH
    if (hipMemsetAsync((char*)d_ws + WS_BAR, 0, XCD_BAR_WORDS * 4, stream) != hipSuccess) { fprintf(stderr, "kernel_launch: hipMemsetAsync failed\n"); return; }
    a.ph_lo = 0; a.ph_hi = N_PHASES;
    void* args[] = {&a};
    hipError_t e = hipLaunchCooperativeKernel((const void*)mega_fwd, dim3(grid), dim3(NTHREADS), args, LDS_BYTES, stream);
    if (e != hipSuccess) fprintf(stderr, "cooperative launch failed: %s (grid %d)\n", hipGetErrorString(e), grid);
#else
    for (int p = 0; p < N_PHASES; ++p) { a.ph_lo = p; a.ph_hi = p + 1; hipLaunchKernelGGL(mega_fwd, dim3(grid), dim3(NTHREADS), LDS_BYTES, stream, a); }
#endif
}
```

```cpp
#include <hip/hip_runtime.h>
#include <hip/hip_cooperative_groups.h>
#include <cstdio>
#include <cstdint>
namespace cg = cooperative_groups;
#ifndef PG8_AUX_A
#define PG8_AUX_A 0
#endif
#ifndef PG8_AUX_B
#define PG8_AUX_B 0
#endif
#ifndef PG8_PFD
#define PG8_PFD 5
#endif
namespace pg8 {
#define PG8_LAS __attribute__((address_space(3)))
typedef unsigned short bf16_t;
typedef short bf16x8 __attribute__((ext_vector_type(8)));
typedef float f32x4 __attribute__((ext_vector_type(4)));
typedef unsigned u32x4 __attribute__((ext_vector_type(4)));
typedef unsigned u32x2 __attribute__((ext_vector_type(2)));
constexpr int BM = 256, BK = 64, HALF = 128, HTB = HALF * BK * 2  , STAGE_BYTES = 8 * HTB, NXCD = 8, WGM = 4;

__host__ __device__ __forceinline__ int lds_byte(int r, int c) { const int st = (r >> 4) * 2 + (c >> 5), rr = r & 15, cc = c & 31, ob = rr * 64 + cc * 2; return st * 1024 + (ob ^ (((ob >> 9) & 1) << 5)); }
__host__ __device__ __forceinline__ void stage_rc(int b, int& R, int& C) { const int st = b / 1024, sb = b % 1024, swz = sb ^ (((sb >> 9) & 1) << 5); R = (st >> 1) * 16 + swz / 64; C = (st & 1) * 32 + (swz % 64) / 2; }
__host__ __device__ __forceinline__ int perm32(int rho) { const int n = rho >> 4, i = rho & 15; return 8 * (i >> 2) + 4 * n + (i & 3); }

__host__ __device__ __forceinline__ int invperm32(int x) { return ((x >> 2) & 1) * 16 + (x >> 3) * 4 + (x & 3); }
__host__ __device__ __forceinline__ size_t tiled_off(int m, int k, int K) { return ((((size_t)(m >> 8) * (size_t)(K >> 6)) + (size_t)(k >> 6)) << 14) + (size_t)(((m >> 7) & 1) << 13) + (size_t)(lds_byte(m & 127, k & 63) >> 1); }
__host__ __device__ __forceinline__ size_t tiled_off_b(int n, int k, int K) { const int r = n & 127, R = (r & ~31) + invperm32(r & 31); return ((((size_t)(n >> 8) * (size_t)(K >> 6)) + (size_t)(k >> 6)) << 14) + (size_t)(((n >> 7) & 1) << 13) + (size_t)(lds_byte(R, k & 63) >> 1); }
struct Unit { int pm, pn; };
struct Gemm { const bf16_t* A; const bf16_t* Bt; int M, N, K; };

struct StaticOrder {
    int nM, nN, nwg, G, c;
    __host__ __device__ void init(int M, int N, int G_, int c_) { nM = M / BM; nN = N / BM; nwg = nM * nN; G = G_; c = c_; }
    __host__ __device__ bool next(int i, Unit& u) const {
        const long L = (long)i * G + c; if (L >= nwg) return false;
        int wgid = (int)L; { const int q = nwg / NXCD, r = nwg % NXCD, xcd = wgid % NXCD, off = wgid / NXCD; wgid = (xcd < r ? xcd * (q + 1) : r * (q + 1) + (xcd - r) * q) + off; }
        const int nig = WGM * nN, gid = wgid / nig, fm = gid * WGM, gsz = (nM - fm) < WGM ? (nM - fm) : WGM;
        u.pm = fm + ((wgid % nig) % gsz); u.pn = (wgid % nig) / gsz; return true;
    }
    __device__ __forceinline__ void a_ready(const Unit&) const {}
    __device__ __forceinline__ void done(const Unit&) const {}
};

typedef float f32x2_cv __attribute__((ext_vector_type(2))); typedef __bf16 bf16x2_cv __attribute__((ext_vector_type(2)));
__device__ __forceinline__ unsigned cvt_pk_bf16(float lo, float hi) { const f32x2_cv v = {lo, hi}; const bf16x2_cv b = __builtin_convertvector(v, bf16x2_cv); return __builtin_bit_cast(unsigned, b); }
typedef float f32x2 __attribute__((ext_vector_type(2)));
__device__ __forceinline__ float fast_sigmoid(float x) { return __builtin_amdgcn_rcpf(1.0f + __builtin_amdgcn_exp2f(-1.4426950408889634f * x)); }
struct EpiStoreBf16 {
    static constexpr bool PERM = true, AFTER_DRAIN = false;
    bf16_t* O; int ldc;
    __device__ __forceinline__ void operator()(const f32x4 (&acc)[2][2][4][2], const Unit& u, int wr, int wc, int fr, int fq) const {
        const int row0 = u.pm * BM + wr * 64 + fr, col0 = u.pn * BM + wc * 32 + 8 * fq;
#pragma unroll
        for (int ai = 0; ai < 2; ++ai)
#pragma unroll
            for (int m = 0; m < 4; ++m) { bf16_t* rowp = O + (size_t)(row0 + ai * HALF + m * 16) * ldc + col0;
#pragma unroll
                for (int bj = 0; bj < 2; ++bj) { const f32x4 v0 = acc[ai][bj][m][0], v1 = acc[ai][bj][m][1];
                    u32x4 w; w.x = cvt_pk_bf16(v0[0], v0[1]); w.y = cvt_pk_bf16(v0[2], v0[3]); w.z = cvt_pk_bf16(v1[0], v1[1]); w.w = cvt_pk_bf16(v1[2], v1[3]);
                    *(u32x4*)(rowp + bj * HALF) = w; } }
    }
};
__device__ __forceinline__ void load_rstd(const float* rsq, int row0, int fq, float (&rstd)[2][4]) {
#pragma unroll
    for (int ai = 0; ai < 2; ++ai)
#pragma unroll
        for (int m = 0; m < 4; ++m) { const f32x4 p = *(const f32x4*)(rsq + (size_t)(row0 + ai * HALF + m * 16) * 16 + 4 * fq); float s = (p[0] + p[1]) + (p[2] + p[3]);
            s += __shfl_xor(s, 16); s += __shfl_xor(s, 32); rstd[ai][m] = rsqrtf(s * (1.0f / 1024.0f) + 1e-6f); }
}
struct EpiGeluSq {
    static constexpr bool PERM = true, AFTER_DRAIN = false;
    bf16_t* O; int ldc; float* vsq; int pn_v; const float* rsq; const float* bias; int nbias;
    __device__ __forceinline__ void operator()(const f32x4 (&acc)[2][2][4][2], const Unit& u, int wr, int wc, int fr, int fq) const {
        const int row0 = u.pm * BM + wr * 64 + fr, col0 = u.pn * BM + wc * 32 + 8 * fq;
        const int cb = u.pm < 32 ? 0 : 1 + ((u.pm - 32) >> 4);
        float rstd[2][4]; load_rstd(rsq, row0, fq, rstd);
        f32x4 bv[2][2];
#pragma unroll
        for (int bj = 0; bj < 2; ++bj)
#pragma unroll
            for (int n = 0; n < 2; ++n) bv[bj][n] = *(const f32x4*)(bias + (size_t)cb * nbias + col0 + bj * HALF + 4 * n);
#pragma unroll
        for (int ai = 0; ai < 2; ++ai)
#pragma unroll
            for (int m = 0; m < 4; ++m) { const int row = row0 + ai * HALF + m * 16; bf16_t* rowp = O + (size_t)row * ldc + col0; float ss = 0.f;
#pragma unroll
                for (int bj = 0; bj < 2; ++bj) { f32x4 v[2];
#pragma unroll
                    for (int n = 0; n < 2; ++n)
#pragma unroll
                        for (int j = 0; j < 4; ++j) { const float x = acc[ai][bj][m][n][j] * rstd[ai][m] + bv[bj][n][j];
                            const float gl = x * __builtin_amdgcn_rcpf(1.0f + __builtin_amdgcn_exp2f(x * (x * x * -0.10294324f + -2.3022082f))); v[n][j] = gl; ss += gl * gl; }
                    u32x4 w; w.x = cvt_pk_bf16(v[0][0], v[0][1]); w.y = cvt_pk_bf16(v[0][2], v[0][3]); w.z = cvt_pk_bf16(v[1][0], v[1][1]); w.w = cvt_pk_bf16(v[1][2], v[1][3]);
                    *(u32x4*)(rowp + bj * HALF) = w; }
                ss += __shfl_xor(ss, 16); ss += __shfl_xor(ss, 32);
                if (u.pn >= pn_v && fq == 0) vsq[(size_t)row * 16 + (u.pn - pn_v) * 4 + wc] = ss; }
    }
};
struct EpiSwiglu {
    static constexpr bool PERM = true, AFTER_DRAIN = false;
    bf16_t* O; int ldc; const float* rsq; const float* bias; int nbias;
    __device__ __forceinline__ void operator()(const f32x4 (&acc)[2][2][4][2], const Unit& u, int wr, int wc, int fr, int fq) const {
        const int row0 = u.pm * BM + wr * 64 + fr, col0 = u.pn * HALF + wc * 32 + 8 * fq;
        const int cb = u.pm < 32 ? 0 : 1 + ((u.pm - 32) >> 4);
        float rstd[2][4]; load_rstd(rsq, row0, fq, rstd);
        f32x4 bv[2][2];
#pragma unroll
        for (int bj = 0; bj < 2; ++bj)
#pragma unroll
            for (int n = 0; n < 2; ++n) bv[bj][n] = *(const f32x4*)(bias + (size_t)cb * nbias + u.pn * BM + bj * HALF + wc * 32 + 8 * fq + 4 * n);
#pragma unroll
        for (int ai = 0; ai < 2; ++ai)
#pragma unroll
            for (int m = 0; m < 4; ++m) { bf16_t* rowp = O + tiled_off(row0 + ai * HALF + m * 16, col0, ldc); f32x4 v[2];
#pragma unroll
                for (int n = 0; n < 2; ++n)
#pragma unroll
                    for (int j = 0; j < 4; ++j) { const float g = acc[ai][0][m][n][j] * rstd[ai][m] + bv[0][n][j], up = acc[ai][1][m][n][j] * rstd[ai][m] + bv[1][n][j]; v[n][j] = g * fast_sigmoid(g) * up; }
                u32x4 w; w.x = cvt_pk_bf16(v[0][0], v[0][1]); w.y = cvt_pk_bf16(v[0][2], v[0][3]); w.z = cvt_pk_bf16(v[1][0], v[1][1]); w.w = cvt_pk_bf16(v[1][2], v[1][3]);
                *(u32x4*)rowp = w; }
    }
};
template <bool F32BASE, bool NORM> struct EpiResidB {
    static constexpr bool PERM = true, AFTER_DRAIN = false;
    const float* b0; const float* b1; const bf16_t* XI; bf16_t* XO; const float* gate; bf16_t* A; const float* gn; const float* sc; float* rsq;
    __device__ __forceinline__ void operator()(const f32x4 (&acc)[2][2][4][2], const Unit& u, int wr, int wc, int fr, int fq) const {
        const int cb = u.pm < 32 ? 0 : 1 + ((u.pm - 32) >> 4);
        const int row0 = u.pm * BM + wr * 64 + fr, col0 = u.pn * BM + wc * 32 + 8 * fq;
        const float* bf = u.pm < 32 ? b0 : b1 - (size_t)8192 * 1024;
        f32x4 gv[2][2], gm[2][2];
#pragma unroll
        for (int bj = 0; bj < 2; ++bj)
#pragma unroll
            for (int n = 0; n < 2; ++n) { const int c = col0 + bj * HALF + 4 * n; gv[bj][n] = *(const f32x4*)(gate + cb * 6144 + c);
                if (NORM) gm[bj][n] = *(const f32x4*)(gn + c) * (*(const f32x4*)(sc + cb * 6144 + c) + 1.0f); }
#pragma unroll
        for (int ai = 0; ai < 2; ++ai)
#pragma unroll
            for (int m = 0; m < 4; ++m) { const int row = row0 + ai * HALF + m * 16; float ss = 0.f;
#pragma unroll
                for (int bj = 0; bj < 2; ++bj) { const size_t off = (size_t)row * 1024 + col0 + bj * HALF; f32x4 x0, x1;
                    if (F32BASE) { x0 = *(const f32x4*)(bf + off); x1 = *(const f32x4*)(bf + off + 4); }
                    else { const u32x4 w = *(const u32x4*)(XI + off); x0 = (f32x4){__uint_as_float(w.x << 16), __uint_as_float(w.x & 0xffff0000u), __uint_as_float(w.y << 16), __uint_as_float(w.y & 0xffff0000u)};
                        x1 = (f32x4){__uint_as_float(w.z << 16), __uint_as_float(w.z & 0xffff0000u), __uint_as_float(w.w << 16), __uint_as_float(w.w & 0xffff0000u)}; }
                    x0 = x0 + gv[bj][0] * acc[ai][bj][m][0]; x1 = x1 + gv[bj][1] * acc[ai][bj][m][1];
                    u32x4 o; o.x = cvt_pk_bf16(x0[0], x0[1]); o.y = cvt_pk_bf16(x0[2], x0[3]); o.z = cvt_pk_bf16(x1[0], x1[1]); o.w = cvt_pk_bf16(x1[2], x1[3]);
                    *(u32x4*)(XO + off) = o;
                    if (NORM) { ss += ((x0[0] * x0[0] + x0[1] * x0[1]) + (x0[2] * x0[2] + x0[3] * x0[3])) + ((x1[0] * x1[0] + x1[1] * x1[1]) + (x1[2] * x1[2] + x1[3] * x1[3]));
                        const f32x4 a0 = x0 * gm[bj][0], a1 = x1 * gm[bj][1];
                        u32x4 q; q.x = cvt_pk_bf16(a0[0], a0[1]); q.y = cvt_pk_bf16(a0[2], a0[3]); q.z = cvt_pk_bf16(a1[0], a1[1]); q.w = cvt_pk_bf16(a1[2], a1[3]);
                        *(u32x4*)(A + tiled_off(row, col0 + bj * HALF, 1024)) = q; } }
                if (NORM) { ss += __shfl_xor(ss, 16); ss += __shfl_xor(ss, 32); if (fq == 0) rsq[(size_t)row * 16 + u.pn * 4 + wc] = ss; } }
    }
};
template <class Epi, class Sched, bool ALIGN_EPI = false, bool SP2 = false>
__device__ __forceinline__ void gemm_phase(PG8_LAS unsigned char* lds, const Gemm g, const Sched& S, const Epi& E) {
    const int tid = threadIdx.x, wid = __builtin_amdgcn_readfirstlane(tid >> 6), lane = tid & 63, wr = wid >> 2, wc = wid & 3, fr = lane & 15, fq = lane >> 4;
    const int K = g.K, nt = K / BK;
    unsigned voffA[2], voffB[2];
#pragma unroll
    for (int i = 0; i < 2; ++i) { voffA[i] = (unsigned)(tid * 16 + i * 8192); voffB[i] = voffA[i]; }
    const size_t kstep = (size_t)(BM * BK * 2);
    const size_t hstep = (size_t)HALF * BK * 2;
    const size_t tstep = (size_t)BM * K * 2;
    const unsigned ldsw = (unsigned)wid * 1024u;
    const int aoff = lds_byte(wr * 64 + fr, fq * 8), boff = lds_byte(wc * 32 + fr, fq * 8);
#define PG8_SA(b, h) (((b) * 2 + (h)) * HTB)
#define PG8_SB(b, h) ((4 + (b) * 2 + (h)) * HTB)
#define PG8_STAGE(bufoff, gbase, voff) do { _Pragma("unroll") for (int _i = 0; _i < 2; ++_i) { \
        if ((bufoff) >= 4 * HTB) __builtin_amdgcn_global_load_lds((const unsigned*)((const char*)(gbase) + (voff)[_i]), (PG8_LAS unsigned*)(lds + (bufoff) + ldsw + _i * 8192), 16, 0, PG8_AUX_B); \
        else __builtin_amdgcn_global_load_lds((const unsigned*)((const char*)(gbase) + (voff)[_i]), (PG8_LAS unsigned*)(lds + (bufoff) + ldsw + _i * 8192), 16, 0, PG8_AUX_A); } } while (0)
#define PG8_LDA(dst, b, h) do { _Pragma("unroll") for (int m = 0; m < 4; ++m) _Pragma("unroll") for (int k = 0; k < 2; ++k) dst[m][k] = *(const PG8_LAS bf16x8*)(lds + PG8_SA(b, h) + aoff + m * 2048 + k * 1024); } while (0)
#define PG8_LDB(dst, b, h) do { _Pragma("unroll") for (int n = 0; n < 2; ++n) _Pragma("unroll") for (int k = 0; k < 2; ++k) dst[n][k] = *(const PG8_LAS bf16x8*)(lds + PG8_SB(b, h) + boff + n * 2048 + k * 1024); } while (0)
#define PG8_MMA(ai, bj, At, Bt) do { __builtin_amdgcn_s_setprio(1); _Pragma("unroll") for (int m = 0; m < 4; ++m) _Pragma("unroll") for (int n = 0; n < 2; ++n) _Pragma("unroll") for (int k = 0; k < 2; ++k) \
        acc[ai][bj][m][n] = __builtin_amdgcn_mfma_f32_16x16x32_bf16(Bt[n][k], At[m][k], acc[ai][bj][m][n], 0, 0, 0); __builtin_amdgcn_s_setprio(0); } while (0)
#define PG8_WAIT_V(n) asm volatile("s_waitcnt vmcnt(" #n ")" ::: "memory")
#define PG8_WAIT_L(n) asm volatile("s_waitcnt lgkmcnt(" #n ")" ::: "memory")
#define PG8_BAR __builtin_amdgcn_s_barrier()
#define PG8_SCHED __builtin_amdgcn_sched_barrier(0)
    Unit cur, nxt; int ui = 0;
    if (!S.next(0, cur)) return;
    f32x4 acc[2][2][4][2];
#pragma unroll
    for (int a = 0; a < 2; ++a)
#pragma unroll
        for (int b = 0; b < 2; ++b)
#pragma unroll
            for (int m = 0; m < 4; ++m)
#pragma unroll
                for (int n = 0; n < 2; ++n) acc[a][b][m][n] = (f32x4){0.f, 0.f, 0.f, 0.f};
    bf16x8 At[4][2], B0[2][2], B1[2][2];
    const char* cA = (const char*)g.A + (size_t)cur.pm * tstep; const char* cB = (const char*)g.Bt + (size_t)cur.pn * tstep;
    S.a_ready(cur);
    if constexpr (SP2) {
        PG8_STAGE(PG8_SB(0, 0), cB, voffB); PG8_STAGE(PG8_SB(0, 1), cB + hstep, voffB); PG8_STAGE(PG8_SA(0, 0), cA, voffA); PG8_STAGE(PG8_SA(0, 1), cA + hstep, voffA);
        if (wr == 1) PG8_BAR;
        PG8_WAIT_V(2); PG8_BAR;
        PG8_STAGE(PG8_SB(1, 0), cB + kstep, voffB); PG8_STAGE(PG8_SA(1, 0), cA + kstep, voffA); PG8_STAGE(PG8_SB(1, 1), cB + hstep + kstep, voffB);
        PG8_WAIT_V(6); PG8_BAR;
    } else {
        PG8_STAGE(PG8_SB(0, 0), cB, voffB); PG8_STAGE(PG8_SA(0, 0), cA, voffA); PG8_STAGE(PG8_SB(0, 1), cB + hstep, voffB); PG8_STAGE(PG8_SA(0, 1), cA + hstep, voffA);
        if (wr == 1) PG8_BAR;
        PG8_WAIT_V(4); PG8_BAR;
        PG8_STAGE(PG8_SB(1, 0), cB + kstep, voffB); PG8_STAGE(PG8_SA(1, 0), cA + kstep, voffA); PG8_STAGE(PG8_SB(1, 1), cB + hstep + kstep, voffB);
        PG8_WAIT_V(6); PG8_BAR;
    }
    for (;;) {
        const bool has_next = S.next(ui + 1, nxt);
        const char* nA = has_next ? (const char*)g.A + (size_t)nxt.pm * tstep : cA; const char* nB = has_next ? (const char*)g.Bt + (size_t)nxt.pn * tstep : cB;
        for (int t = 0; t < nt; t += 2) {
            const bool last = (t == nt - 2);
            const char* a1 = cA + (size_t)(t + 1) * kstep;
            const char* a2 = last ? nA : cA + (size_t)(t + 2) * kstep; const char* b2 = last ? nB : cB + (size_t)(t + 2) * kstep;
            const char* a3 = a2 + kstep; const char* b3 = b2 + kstep;
            if (last && has_next) S.a_ready(nxt);
            if constexpr (SP2) {
            PG8_LDB(B0, 0, 0); PG8_LDB(B1, 0, 1); PG8_SCHED; PG8_LDA(At, 0, 0); PG8_STAGE(PG8_SA(1, 1), a1 + hstep, voffA);
            PG8_WAIT_V(8); PG8_WAIT_L(0); PG8_BAR; PG8_MMA(0, 0, At, B0); PG8_MMA(0, 1, At, B1); PG8_BAR; PG8_SCHED;
            PG8_LDA(At, 0, 1); PG8_STAGE(PG8_SB(0, 0), b2, voffB); PG8_STAGE(PG8_SB(0, 1), b2 + hstep, voffB); PG8_STAGE(PG8_SA(0, 0), a2, voffA);
            PG8_WAIT_V(8); PG8_WAIT_L(0); PG8_BAR; PG8_MMA(1, 0, At, B0); PG8_MMA(1, 1, At, B1); PG8_BAR; PG8_SCHED;
            PG8_LDB(B0, 1, 0); PG8_LDB(B1, 1, 1); PG8_SCHED; PG8_LDA(At, 1, 0); PG8_STAGE(PG8_SA(0, 1), a2 + hstep, voffA);
            PG8_WAIT_V(8); PG8_WAIT_L(0); PG8_BAR; PG8_MMA(0, 0, At, B0); PG8_MMA(0, 1, At, B1); PG8_BAR; PG8_SCHED;
            PG8_LDA(At, 1, 1); PG8_STAGE(PG8_SB(1, 0), b3, voffB); PG8_STAGE(PG8_SB(1, 1), b3 + hstep, voffB); PG8_STAGE(PG8_SA(1, 0), a3, voffA);
            PG8_WAIT_V(8); PG8_WAIT_L(0); PG8_BAR; PG8_MMA(1, 0, At, B0); PG8_MMA(1, 1, At, B1); PG8_BAR; PG8_SCHED;
            } else {
            PG8_LDB(B0, 0, 0); PG8_SCHED; PG8_LDA(At, 0, 0); PG8_STAGE(PG8_SA(1, 1), a1 + hstep, voffA);
            PG8_WAIT_L(8); PG8_BAR; PG8_WAIT_L(0); PG8_MMA(0, 0, At, B0); PG8_BAR; PG8_SCHED;
            PG8_LDB(B1, 0, 1); PG8_STAGE(PG8_SB(0, 0), b2, voffB);
            PG8_BAR; PG8_WAIT_L(0); PG8_MMA(0, 1, At, B1); PG8_BAR;
            PG8_LDA(At, 0, 1); PG8_STAGE(PG8_SA(0, 0), a2, voffA);
            PG8_BAR; PG8_WAIT_L(0); PG8_MMA(1, 0, At, B0); PG8_BAR; PG8_SCHED;
            PG8_STAGE(PG8_SB(0, 1), b2 + hstep, voffB);
            PG8_WAIT_V(6); PG8_BAR; PG8_MMA(1, 1, At, B1); PG8_BAR;
            PG8_LDB(B0, 1, 0); PG8_SCHED; PG8_LDA(At, 1, 0); PG8_STAGE(PG8_SA(0, 1), a2 + hstep, voffA);
            PG8_WAIT_L(8); PG8_BAR; PG8_WAIT_L(0); PG8_MMA(0, 0, At, B0); PG8_BAR; PG8_SCHED;
            PG8_LDB(B1, 1, 1); PG8_STAGE(PG8_SB(1, 0), b3, voffB);
            PG8_BAR; PG8_WAIT_L(0); PG8_MMA(0, 1, At, B1); PG8_BAR;
            PG8_LDA(At, 1, 1); PG8_STAGE(PG8_SA(1, 0), a3, voffA);
            PG8_BAR; PG8_WAIT_L(0); PG8_MMA(1, 0, At, B0); PG8_BAR; PG8_SCHED;
            PG8_STAGE(PG8_SB(1, 1), b3 + hstep, voffB);
            PG8_WAIT_V(6); PG8_BAR; PG8_MMA(1, 1, At, B1); PG8_BAR;
            }
        }
        if constexpr (ALIGN_EPI) { if (wr == 0) PG8_BAR; }
        if constexpr (!Epi::AFTER_DRAIN) { E(acc, cur, wr, wc, fr, fq); S.done(cur); }
        if (!has_next) break;
#pragma unroll
        for (int a = 0; a < 2; ++a)
#pragma unroll
            for (int b = 0; b < 2; ++b)
#pragma unroll
                for (int m = 0; m < 4; ++m)
#pragma unroll
                    for (int n = 0; n < 2; ++n) acc[a][b][m][n] = (f32x4){0.f, 0.f, 0.f, 0.f};
        cur = nxt; cA = nA; cB = nB; ++ui;
        if constexpr (ALIGN_EPI) { if (wr == 1) PG8_BAR; }
    }
    PG8_WAIT_V(0);
    if constexpr (!ALIGN_EPI) { if (wr == 0) PG8_BAR; }
    PG8_BAR;
    if constexpr (Epi::AFTER_DRAIN) { E.fused(acc, cur, wr, wc, fr, fq, lds, wid, lane); S.done(cur); }
#undef PG8_SA
#undef PG8_SB
#undef PG8_STAGE
#undef PG8_LDA
#undef PG8_LDB
#undef PG8_MMA
#undef PG8_WAIT_V
#undef PG8_WAIT_L
#undef PG8_BAR
#undef PG8_SCHED
}
}
constexpr int D = 1024, MCTX = 8192, MLAT = 32768, M = MCTX + MLAT;
constexpr int NAB = 3584, FF = 2816, NGU = 2 * FF, NC = 2048, NCOND = 9, MODW = 6 * D;
constexpr float EPS = 1e-6f;
constexpr int NWAVES = 8, NTHREADS = 512;
#ifndef ONE_LAUNCH
#define ONE_LAUNCH 1
#endif
constexpr int N_PHASES = 18;
#ifndef PH_MASK
#define PH_MASK 0x3ffff
#endif
#ifndef STAG_TICKS
#define STAG_TICKS 0
#endif
#ifndef ONE_LAUNCH
#define ONE_LAUNCH 1
#endif
constexpr size_t MiB = 1u << 20;
constexpr size_t WS_MOD = 0;
constexpr size_t WS_ROPE = 1 * MiB;
constexpr size_t WS_VSQ = 2 * MiB;
constexpr size_t WS_SHW = 512 * 1024;
constexpr size_t WS_RSQ = 4 * MiB + 512 * 1024;
constexpr size_t WS_BAR = 7 * MiB + 512 * 1024;
constexpr size_t WS_WAB = 8 * MiB;
constexpr size_t WS_WOAB = 15 * MiB;
constexpr size_t WS_WINC = 17 * MiB;
constexpr size_t WS_WOC = 21 * MiB;
constexpr size_t WS_WGU = 23 * MiB;
constexpr size_t WS_WDN = 45 * MiB;
constexpr size_t WS_HB = 56 * MiB;
constexpr size_t WS_YB = 136 * MiB;
constexpr size_t WS_P = 216 * MiB;
constexpr size_t WS_END = 496 * MiB;
constexpr int LDS_BYTES = 147456;
constexpr int MISC_OFF = LDS_BYTES - 64;
constexpr int TS = 136, TILE_B = 128 * TS * 2;
constexpr int VS = 264;

#define LAS __attribute__((address_space(3)))
typedef unsigned short bf16;
typedef unsigned v4u __attribute__((ext_vector_type(4)));
typedef unsigned v2u __attribute__((ext_vector_type(2)));
typedef float f32x4 __attribute__((ext_vector_type(4)));
typedef short bf16x8 __attribute__((ext_vector_type(8)));
typedef short s16x4 __attribute__((ext_vector_type(4)));
typedef LAS unsigned char* ldsp;

__device__ __forceinline__ float bflo(unsigned w) { return __uint_as_float(w << 16); }
__device__ __forceinline__ float bfhi(unsigned w) { return __uint_as_float(w & 0xffff0000u); }
__device__ __forceinline__ unsigned pk2(float lo, float hi) { return pg8::cvt_pk_bf16(lo, hi); }
__device__ __forceinline__ s16x4 vtr(const LAS unsigned char* p) { return __builtin_bit_cast(s16x4, __builtin_amdgcn_ds_read_tr16_b64_v4i16((LAS s16x4*)p)); }
__device__ __forceinline__ bf16x8 tr_frag(const LAS unsigned char* p, int off2) { const s16x4 a = vtr(p), b = vtr(p + off2); return __builtin_shufflevector(a, b, 0, 1, 2, 3, 4, 5, 6, 7); }
__device__ __forceinline__ f32x4 mfma16(bf16x8 a, bf16x8 b, f32x4 c) { return __builtin_amdgcn_mfma_f32_16x16x32_bf16(a, b, c, 0, 0, 0); }
__device__ __forceinline__ float wave_sum(float v) {
#pragma unroll
    for (int o = 1; o < 64; o <<= 1) v += __shfl_xor(v, o);
    return v;
}
__device__ __forceinline__ float log2_sigmoid(float x) { return -log1pf(expf(-x)) * 1.4426950408889634f; }

struct Args {
    const float* in[24]; float* out; unsigned char* ws; int ph_lo, ph_hi;
};

__device__ __forceinline__ void transpose_item(const float* W, int K, int N, bf16* WT, int k0, int n0, int dst_row0, float scale, LAS float* scr, int lane) {
    float wv[32];
#pragma unroll
    for (int i = 0; i < 32; ++i) wv[i] = W[(size_t)(k0 + 2 * i + (lane >> 5)) * N + n0 + (lane & 31)];
#pragma unroll
    for (int i = 0; i < 32; ++i) scr[(2 * i + (lane >> 5)) * 33 + (lane & 31)] = wv[i];
    asm volatile("s_waitcnt lgkmcnt(0)" ::: "memory");
    const int c = lane & 7;
#pragma unroll
    for (int j = 0; j < 4; ++j) { const int n = (lane >> 3) + 8 * j; const LAS float* s = scr + (8 * c) * 33 + n;
        v4u o; o.x = pk2(s[0 * 33] * scale, s[1 * 33] * scale); o.y = pk2(s[2 * 33] * scale, s[3 * 33] * scale); o.z = pk2(s[4 * 33] * scale, s[5 * 33] * scale); o.w = pk2(s[6 * 33] * scale, s[7 * 33] * scale);
        *(v4u*)(WT + pg8::tiled_off_b(dst_row0 + n, k0 + 8 * c, K)) = o; }
    asm volatile("s_waitcnt lgkmcnt(0)" ::: "memory");
}

constexpr int CONV_FIRST = 2304, CONV_EARLY = 5120, CONV_ALL = 12288;
__device__ __forceinline__ void convert_range(const Args& a, ldsp lds, int it_lo, int it_hi, int gw, int NGW, int lane, int wave) {
    unsigned char* ws = a.ws; LAS float* scr = (LAS float*)lds + wave * (64 * 33);
    for (int it = it_lo + gw; it < it_hi; it += NGW) {
        int r = it; const float* W; int K, N; bf16* WT; int mode = 0;
        if (r < 1792) { W = a.in[9]; K = 1024; N = NAB; WT = (bf16*)(ws + WS_WAB); mode = 3; }
        else if ((r -= 1792) < 512) { W = a.in[14]; K = 1024; N = 1024; WT = (bf16*)(ws + WS_WOAB); }
        else if ((r -= 512) < 1408) { W = a.in[20]; K = 1024; N = FF; WT = (bf16*)(ws + WS_WGU); mode = 1; }
        else if ((r -= 1408) < 1408) { W = a.in[21]; K = 1024; N = FF; WT = (bf16*)(ws + WS_WGU); mode = 2; }
        else if ((r -= 1408) < 1408) { W = a.in[22]; K = FF; N = 1024; WT = (bf16*)(ws + WS_WDN); }
        else if ((r -= 1408) < 1024) { W = a.in[15]; K = 1024; N = NC; WT = (bf16*)(ws + WS_WINC); }
        else if ((r -= 1024) < 512) { W = a.in[19]; K = 1024; N = 1024; WT = (bf16*)(ws + WS_WOC); }
        else if ((r -= 512) < 1408) { W = a.in[20] + (size_t)1024 * FF; K = 1024; N = FF; WT = (bf16*)(ws + WS_WGU) + (size_t)NGU * 1024; mode = 1; }
        else if ((r -= 1408) < 1408) { W = a.in[21] + (size_t)1024 * FF; K = 1024; N = FF; WT = (bf16*)(ws + WS_WGU) + (size_t)NGU * 1024; mode = 2; }
        else { r -= 1408; W = a.in[22] + (size_t)FF * 1024; K = FF; N = 1024; WT = (bf16*)(ws + WS_WDN) + (size_t)1024 * FF; }
        const int nblk = N / 32, kb = r / nblk, nb = r % nblk, k0 = 64 * kb, n0 = 32 * nb;
        int drow = n0; float scale = 1.0f;
        if (mode == 1) drow = (n0 >> 7) * 256 + (n0 & 127);
        else if (mode == 2) drow = (n0 >> 7) * 256 + 128 + (n0 & 127);
        else if (mode == 3 && n0 < 512) scale = 0.08838834764831845f;
        transpose_item(W, K, N, WT, k0, n0, drow, scale, scr, lane);
    }
}

__device__ __forceinline__ void p0_prologue(const Args& a, ldsp lds, int tid, int lane, int wave) {
    unsigned char* ws = a.ws;
    LAS float* L = (LAS float*)lds;
    const int bx = blockIdx.x, G = gridDim.x;
    for (int job = bx; job < 192; job += G) {
        const float* c = a.in[3]; const float* c_ctx = a.in[4]; const float* ada_w = a.in[5]; const float* ada_b = a.in[6];
        float* mod = (float*)(ws + WS_MOD);
        for (int e = tid; e < NCOND * 1024; e += NTHREADS) { const int b = e >> 10, k = e & 1023; const float cv = (b == 0) ? c_ctx[k] : c[(b - 1) * 1024 + k]; L[e] = cv / (1.0f + __expf(-cv)); }
        __syncthreads();
        const int l = job / 96, n0 = (job % 96) * 64;
        const float* W = ada_w + ((size_t)l * 1024 + 128 * wave) * MODW + n0 + lane;
        float acc[NCOND];
#pragma unroll
        for (int b = 0; b < NCOND; ++b) acc[b] = 0.f;
        for (int kk = 0; kk < 128; kk += 32) {
            float w[32];
#pragma unroll
            for (int u = 0; u < 32; ++u) w[u] = W[(size_t)(kk + u) * MODW];
#pragma unroll
            for (int u = 0; u < 32; ++u)
#pragma unroll
                for (int b = 0; b < NCOND; ++b) acc[b] += L[b * 1024 + 128 * wave + kk + u] * w[u];
        }
        LAS float* red = L + NCOND * 1024;
#pragma unroll
        for (int b = 0; b < NCOND; ++b) red[(wave * NCOND + b) * 64 + lane] = acc[b];
        __syncthreads();
        for (int e = tid; e < NCOND * 64; e += NTHREADS) { const int b = e >> 6, ln = e & 63; float s = ada_b[l * MODW + n0 + ln];
#pragma unroll
            for (int w = 0; w < 8; ++w) s += red[(w * NCOND + b) * 64 + ln];
            mod[(size_t)(l * NCOND + b) * MODW + n0 + ln] = s; }
        __syncthreads();
    }
    if (bx == G - 1) {
        float* tab = (float*)(ws + WS_ROPE);
        for (int e = tid; e < 2048; e += NTHREADS) { const int pos = e >> 5, f = e & 31; const float fr = exp2f(-(float)f * (13.287712379549449f / 32.0f)); const float ang = (float)pos * fr;
            float rev = ang * 0.15915494309189535f; rev -= floorf(rev); tab[e] = __builtin_amdgcn_cosf(rev); tab[2048 + e] = __builtin_amdgcn_sinf(rev); }
    }
    convert_range(a, lds, 0, G == 256 ? CONV_FIRST : CONV_ALL, bx * NWAVES + wave, G * NWAVES, lane, wave);
}

template <bool FIRST>
__device__ __forceinline__ void norm_pass(const Args& a, const float* gn, const float* modl, int off_sh, int off_sc, bf16* outp, int lane, int wave) {
    const int gw = blockIdx.x * NWAVES + wave, NGW = gridDim.x * NWAVES;
    for (int m0 = gw; m0 < M; m0 += 2 * NGW) {
        const int m1 = m0 + NGW; const bool two = m1 < M;
        f32x4 v[2][4]; float s[2] = {0.f, 0.f};
#pragma unroll
        for (int q = 0; q < 2; ++q) { const int m = (q == 0 || two) ? (q == 0 ? m0 : m1) : m0;
            const float* xrow = FIRST ? (m < MCTX ? a.in[0] + (size_t)m * D : a.in[1] + (size_t)(m - MCTX) * D) : a.out + (size_t)m * D;
            const f32x4* xr = (const f32x4*)xrow + lane;
#pragma unroll
            for (int j = 0; j < 4; ++j) v[q][j] = xr[64 * j]; }
#pragma unroll
        for (int q = 0; q < 2; ++q) {
#pragma unroll
            for (int j = 0; j < 4; ++j) s[q] += (v[q][j].x * v[q][j].x + v[q][j].y * v[q][j].y) + (v[q][j].z * v[q][j].z + v[q][j].w * v[q][j].w); }
#pragma unroll
        for (int q = 0; q < 2; ++q) { if (q == 1 && !two) break; const int m = q == 0 ? m0 : m1;
            const int cb = m < MCTX ? 0 : 1 + ((m - MCTX) >> 12);
            const float rstd = rsqrtf(wave_sum(s[q]) * (1.0f / D) + EPS);
            const float* mrow = modl + (size_t)cb * MODW;
#pragma unroll
            for (int j = 0; j < 4; ++j) { const int col = 4 * lane + 256 * j;
                const f32x4 g4 = *(const f32x4*)(gn + col), sc4 = *(const f32x4*)(mrow + off_sc + col), sh4 = *(const f32x4*)(mrow + off_sh + col);
                const f32x4 o = v[q][j] * rstd * g4 * (sc4 + 1.0f) + sh4;
                v2u w; w.x = pk2(o.x, o.y); w.y = pk2(o.z, o.w); *(v2u*)(outp + pg8::tiled_off(m, col, D)) = w; } }
    }
}
__device__ __forceinline__ void final_norm(const Args& a, const float* gn, int lane, int wave) {
    const int gw = blockIdx.x * NWAVES + wave, NGW = gridDim.x * NWAVES;
    for (int m = gw; m < M; m += NGW) {
        f32x4* xr = (f32x4*)(a.out + (size_t)m * D) + lane;
        f32x4 v[4]; float s = 0.f;
#pragma unroll
        for (int j = 0; j < 4; ++j) { v[j] = xr[64 * j]; s += (v[j].x * v[j].x + v[j].y * v[j].y) + (v[j].z * v[j].z + v[j].w * v[j].w); }
        const float rstd = rsqrtf(wave_sum(s) * (1.0f / D) + EPS);
#pragma unroll
        for (int j = 0; j < 4; ++j) { const f32x4 g4 = *(const f32x4*)(gn + 4 * lane + 256 * j); xr[64 * j] = v[j] * rstd * g4; }
    }
}

__device__ __forceinline__ void ld_tile(const bf16* src, int tid, v4u (&x)[2][2]) {
#pragma unroll
    for (int rep = 0; rep < 2; ++rep) { const int it = tid + rep * NTHREADS, tok = it >> 3, d0 = (it & 7) * 8;
        x[rep][0] = *(const v4u*)(src + (size_t)tok * NAB + d0); x[rep][1] = *(const v4u*)(src + (size_t)tok * NAB + 64 + d0); }
}
__device__ __forceinline__ void st_rope_tile(ldsp T, const v4u (&x)[2][2], bool rope, int tpos0, const float* tab, int tid) {
#pragma unroll
    for (int rep = 0; rep < 2; ++rep) { const int it = tid + rep * NTHREADS, tok = it >> 3, d0 = (it & 7) * 8;
        v4u x1 = x[rep][0], x2 = x[rep][1];
        if (rope) { const int tpos = tpos0 + tok, pos = d0 < 32 ? (tpos >> 6) : (tpos & 63), f0 = d0 & 31;
            const f32x4 c0 = *(const f32x4*)(tab + pos * 32 + f0), c1 = *(const f32x4*)(tab + pos * 32 + f0 + 4), s0 = *(const f32x4*)(tab + 2048 + pos * 32 + f0), s1 = *(const f32x4*)(tab + 2048 + pos * 32 + f0 + 4);
            const float cs[8] = {c0.x, c0.y, c0.z, c0.w, c1.x, c1.y, c1.z, c1.w}, sn[8] = {s0.x, s0.y, s0.z, s0.w, s1.x, s1.y, s1.z, s1.w};
            v4u o1, o2;
#pragma unroll
            for (int w = 0; w < 4; ++w) { const float a0 = bflo(x1[w]), a1 = bfhi(x1[w]), b0 = bflo(x2[w]), b1 = bfhi(x2[w]);
                o1[w] = pk2(a0 * cs[2 * w] - b0 * sn[2 * w], a1 * cs[2 * w + 1] - b1 * sn[2 * w + 1]);
                o2[w] = pk2(b0 * cs[2 * w] + a0 * sn[2 * w], b1 * cs[2 * w + 1] + a1 * sn[2 * w + 1]); }
            x1 = o1; x2 = o2; }
        *(LAS v4u*)(T + (tok * TS + d0) * 2) = x1; *(LAS v4u*)(T + (tok * TS + 64 + d0) * 2) = x2; }
}
__device__ __forceinline__ void ld_vtile(const bf16* src, int tid, v4u (&x)[4]) {
#pragma unroll
    for (int rep = 0; rep < 4; ++rep) { const int it = tid + rep * NTHREADS, tok = it >> 4, ch = it & 15; x[rep] = *(const v4u*)(src + (size_t)tok * NAB + ch * 8); }
}

__device__ __forceinline__ void r1_phase(const Args& a, ldsp lds, int tid0, int lane, int wave) {
    const bf16* P = (const bf16*)(a.ws + WS_P); bf16* UB = (bf16*)(a.ws + WS_YB); const float* tab = (const float*)(a.ws + WS_ROPE);
    const ldsp Kt = lds, Vf = lds + TILE_B, Vb = lds + 2 * TILE_B;
    const int r0 = lane & 15, kq0 = lane >> 4;
    v4u pk_[2][2], pv_[4];
    if ((int)blockIdx.x < 1280) { const int u = blockIdx.x; const bf16* Pg = P + (size_t)(u >> 2) * 128 * NAB; ld_tile(Pg + 512 + (u & 3) * 128, tid0, pk_); ld_vtile(Pg + 1024 + (u & 3) * 128, tid0, pv_); }
    for (int u = blockIdx.x; u < 1280; u += gridDim.x) {
        const int cidx = u >> 2, h = u & 3, row0 = cidx * 128; const bool lat = cidx >= 64; const int tpos0 = lat ? ((cidx - 64) & 31) * 128 : 0;
        const float l2f = log2_sigmoid(a.in[10][h]), l2b = log2_sigmoid(a.in[10][4 + h]);
        int tid = tid0, r = r0, kq = kq0; asm volatile("" : "+v"(tid), "+v"(r), "+v"(kq));
        __syncthreads();
        st_rope_tile(Kt, pk_, lat, tpos0, tab, tid);
#pragma unroll
        for (int rep = 0; rep < 4; ++rep) { const int it = tid + rep * NTHREADS, tok = it >> 4, ch = it & 15;
            const v4u x = pv_[rep];
            const float sf = __builtin_amdgcn_exp2f((float)(127 - tok) * l2f), sb = __builtin_amdgcn_exp2f((float)tok * l2b);
            v4u of, ob;
#pragma unroll
            for (int w = 0; w < 4; ++w) { const float lo = bflo(x[w]), hi = bfhi(x[w]); of[w] = pk2(lo * sf, hi * sf); ob[w] = pk2(lo * sb, hi * sb); }
            *(LAS v4u*)(Vf + (tok * TS + ch * 8) * 2) = of; *(LAS v4u*)(Vb + (tok * TS + ch * 8) * 2) = ob; }
        __syncthreads();
        { const int un = u + gridDim.x; if (un < 1280) { const bf16* Pn = P + (size_t)(un >> 2) * 128 * NAB; ld_tile(Pn + 512 + (un & 3) * 128, tid, pk_); ld_vtile(Pn + 1024 + (un & 3) * 128, tid, pv_); } }
        f32x4 acc[2][8];
#pragma unroll
        for (int d = 0; d < 2; ++d)
#pragma unroll
            for (int mt = 0; mt < 8; ++mt) acc[d][mt] = (f32x4){0.f, 0.f, 0.f, 0.f};
#pragma unroll
        for (int ks = 0; ks < 4; ++ks) { const int j0 = ks * 32 + kq * 8 + (r >> 2);
            const bf16x8 vfa = tr_frag(Vf + (j0 * TS + 16 * wave + 4 * (r & 3)) * 2, 8 * TS), vba = tr_frag(Vb + (j0 * TS + 16 * wave + 4 * (r & 3)) * 2, 8 * TS);
#pragma unroll
            for (int mt = 0; mt < 8; ++mt) { const bf16x8 ka = tr_frag(Kt + (j0 * TS + mt * 16 + 4 * (r & 3)) * 2, 8 * TS);
                acc[0][mt] = mfma16(ka, vfa, acc[0][mt]); acc[1][mt] = mfma16(ka, vba, acc[1][mt]); } }
#pragma unroll
        for (int d = 0; d < 2; ++d)
#pragma unroll
            for (int mt = 0; mt < 8; ++mt) { v2u w; w.x = pk2(acc[d][mt][0], acc[d][mt][1]); w.y = pk2(acc[d][mt][2], acc[d][mt][3]);
                *(v2u*)(UB + ((size_t)(u * 2 + d) * 128 + 16 * wave + r) * 128 + mt * 16 + 4 * kq) = w; }
    }
}

constexpr int SCAN_B = 8;
__device__ __forceinline__ void scan_item(const bf16* UB, bf16* SB, int cidx0, int n, int h, int dir, int e8, float dec, const float* S0, float* Sout) {
    const int dv = e8 >> 4, dk0 = (e8 & 15) * 8;
    float S[8];
#pragma unroll
    for (int i = 0; i < 8; ++i) S[i] = S0 ? S0[(size_t)(dk0 + i) * 128 + dv] : 0.f;
    for (int s0 = 0; s0 < n; s0 += SCAN_B) {
        v4u uu[SCAN_B]; size_t off[SCAN_B];
#pragma unroll
        for (int j = 0; j < SCAN_B; ++j) { const int st = s0 + j, c = dir == 0 ? st : n - 1 - st; off[j] = ((size_t)((cidx0 + c) * 4 + h) * 2 + dir) * 16384 + (size_t)e8 * 8;
            if (st < n) uu[j] = *(const v4u*)(UB + off[j]); else uu[j] = (v4u){0u, 0u, 0u, 0u}; }
#pragma unroll
        for (int j = 0; j < SCAN_B; ++j) { if (s0 + j < n) {
            v4u so; so.x = pk2(S[0], S[1]); so.y = pk2(S[2], S[3]); so.z = pk2(S[4], S[5]); so.w = pk2(S[6], S[7]);
            *(v4u*)(SB + off[j]) = so;
#pragma unroll
            for (int w = 0; w < 4; ++w) { S[2 * w] = dec * S[2 * w] + bflo(uu[j][w]); S[2 * w + 1] = dec * S[2 * w + 1] + bfhi(uu[j][w]); } } }
    }
    if (Sout) {
#pragma unroll
        for (int i = 0; i < 8; ++i) Sout[(size_t)(dk0 + i) * 128 + dv] = S[i]; }
}
__device__ __forceinline__ void r2_phase(const Args& a, int tid) {
    const bf16* UB = (const bf16*)(a.ws + WS_YB); bf16* SB = (bf16*)(a.ws + WS_HB);
    const int NT = gridDim.x * NTHREADS;
    for (int t = blockIdx.x * NTHREADS + tid; t < 131072; t += NT) {
        const int e8 = t & 2047, dir = (t >> 11) & 1, h = (t >> 12) & 3, s = t >> 14;
        const float dec = exp2f(128.0f * log2_sigmoid(a.in[10][dir * 4 + h]));
        scan_item(UB, SB, 64 + s * 32, 32, h, dir, e8, dec, a.in[2] + (size_t)((s * 2 + dir) * 4 + h) * 16384, nullptr);
    }
    for (int t = blockIdx.x * NTHREADS + tid; t < 524288; t += NT) {
        const int e8 = t & 2047, dir = (t >> 11) & 1, h = (t >> 12) & 3, s = t >> 14;
        const float dec = exp2f(128.0f * log2_sigmoid(a.in[10][dir * 4 + h]));
        scan_item(UB, SB, s * 2, 2, h, dir, e8, dec, nullptr, a.out + (size_t)M * D + (size_t)((s * 2 + dir) * 4 + h) * 16384);
    }
}

__device__ __forceinline__ void r3_phase(const Args& a, ldsp lds, int tid0, int lane, int wave) {
    const bf16* P = (const bf16*)(a.ws + WS_P); const bf16* SB = (const bf16*)(a.ws + WS_HB); bf16* YB = (bf16*)(a.ws + WS_YB); const float* tab = (const float*)(a.ws + WS_ROPE);
    const ldsp Qt = lds, Kt = lds + TILE_B, Vt = lds + 2 * TILE_B, Pt = lds + 3 * TILE_B;
    const int r0 = lane & 15, kq0 = lane >> 4;
#ifndef NO_RET
    v4u pq_[2][2], pk_[2][2], pv_[4];
    v4u pg_[4];
    if ((int)blockIdx.x < 1280) { const int u = blockIdx.x, ln = tid0 & 63; const bf16* gp = P + (size_t)((u >> 2) * 128 + 16 * wave + (ln >> 2)) * NAB + 1536 + (u & 3) * 128 + (ln & 3) * 32;
#pragma unroll
        for (int k = 0; k < 4; ++k) pg_[k] = *(const v4u*)(gp + k * 8); }
    if ((int)blockIdx.x < 1280) { const int u = blockIdx.x; const bf16* Pg0 = P + (size_t)(u >> 2) * 128 * NAB; ld_tile(Pg0 + (u & 3) * 128, tid0, pq_); ld_tile(Pg0 + 512 + (u & 3) * 128, tid0, pk_); ld_vtile(Pg0 + 1024 + (u & 3) * 128, tid0, pv_); }
    for (int u = blockIdx.x; u < 1280; u += gridDim.x) {
        const int cidx = u >> 2, h = u & 3, row0 = cidx * 128; const bool lat = cidx >= 64; const int tpos0 = lat ? ((cidx - 64) & 31) * 128 : 0;
        const float l2f = log2_sigmoid(a.in[10][h]), l2b = log2_sigmoid(a.in[10][4 + h]);
        const bf16* Pg = P + (size_t)row0 * NAB;
        int tid = tid0, r = r0, kq = kq0; asm volatile("" : "+v"(tid), "+v"(r), "+v"(kq));
        __syncthreads();
        st_rope_tile(Qt, pq_, lat, tpos0, tab, tid);
        st_rope_tile(Kt, pk_, lat, tpos0, tab, tid);
#pragma unroll
        for (int rep = 0; rep < 4; ++rep) { const int it = tid + rep * NTHREADS, tok = it >> 4, ch = it & 15; *(LAS v4u*)(Vt + (tok * TS + ch * 8) * 2) = pv_[rep]; }
        __syncthreads();
        { const int un = u + gridDim.x; if (un < 1280) { const bf16* Pn = P + (size_t)(un >> 2) * 128 * NAB; ld_tile(Pn + (un & 3) * 128, tid, pq_); ld_tile(Pn + 512 + (un & 3) * 128, tid, pk_); ld_vtile(Pn + 1024 + (un & 3) * 128, tid, pv_); } }
        const int il = 16 * wave + r;
        int ilq = il - 4 * kq; asm volatile("" : "+v"(ilq));
        bf16x8 qf[4];
#pragma unroll
        for (int ks = 0; ks < 4; ++ks) qf[ks] = *(const LAS bf16x8*)(Qt + (il * TS + ks * 32 + kq * 8) * 2);
#pragma unroll
        for (int nt = 0; nt < 8; ++nt) { f32x4 c = (f32x4){0.f, 0.f, 0.f, 0.f};
#pragma unroll
            for (int ks = 0; ks < 4; ++ks) { const bf16x8 kf = *(const LAS bf16x8*)(Kt + ((nt * 16 + r) * TS + ks * 32 + kq * 8) * 2); c = mfma16(kf, qf[ks], c); }
            float p[4];
#pragma unroll
            for (int e = 0; e < 4; ++e) { const float fd = (float)(ilq - (nt * 16 + e));
                const float dm = (fd == 0.0f) ? 2.0f : __builtin_amdgcn_exp2f(fmaxf(fd, 0.0f) * l2f + fmaxf(-fd, 0.0f) * l2b); p[e] = c[e] * dm; }
            v2u w; w.x = pk2(p[0], p[1]); w.y = pk2(p[2], p[3]);
            *(LAS v2u*)(Pt + (il * TS + nt * 16 + 4 * kq) * 2) = w; asm volatile("" ::: "memory"); }
        asm volatile("s_waitcnt lgkmcnt(0)" ::: "memory");
        __syncthreads();
        v4u sreg[4];
        { const bf16* Sg = SB + (size_t)(u * 2) * 16384;
#pragma unroll
          for (int rep = 0; rep < 4; ++rep) { const int it = tid + rep * NTHREADS; sreg[rep] = *(const v4u*)(Sg + (it >> 4) * 128 + (it & 15) * 8); } }
        f32x4 oi[8];
#pragma unroll
        for (int nt = 0; nt < 8; ++nt) oi[nt] = (f32x4){0.f, 0.f, 0.f, 0.f};
#pragma unroll
        for (int ks = 0; ks < 4; ++ks) { const bf16x8 pf = *(const LAS bf16x8*)(Pt + (il * TS + ks * 32 + kq * 8) * 2); const int j0 = ks * 32 + kq * 8 + (r >> 2);
#pragma unroll
            for (int nt = 0; nt < 8; ++nt) { const bf16x8 vf = tr_frag(Vt + (j0 * TS + nt * 16 + 4 * (r & 3)) * 2, 8 * TS); oi[nt] = mfma16(pf, vf, oi[nt]); }
            asm volatile("" ::: "memory"); }
#pragma unroll
        for (int rep = 0; rep < 4; ++rep) { const int it = tid + rep * NTHREADS; *(LAS v4u*)(Kt + ((it >> 4) * TS + (it & 15) * 8) * 2) = sreg[rep]; }
        __syncthreads();
        { const bf16* Sg = SB + (size_t)(u * 2 + 1) * 16384;
#pragma unroll
          for (int rep = 0; rep < 4; ++rep) { const int it = tid + rep * NTHREADS; sreg[rep] = *(const v4u*)(Sg + (it >> 4) * 128 + (it & 15) * 8); } }
        int iq = 16 * wave + 4 * kq; asm volatile("" : "+v"(iq));
#pragma unroll
        for (int dir = 0; dir < 2; ++dir) {
            const ldsp St = dir == 0 ? Kt : Vt;
            if (dir == 1) {
#pragma unroll
                for (int rep = 0; rep < 4; ++rep) { const int it = tid + rep * NTHREADS; *(LAS v4u*)(Vt + ((it >> 4) * TS + (it & 15) * 8) * 2) = sreg[rep]; }
                __syncthreads();
            }
            float cr[4];
#pragma unroll
            for (int e = 0; e < 4; ++e) cr[e] = dir == 0 ? __builtin_amdgcn_exp2f((float)(iq + e + 1) * l2f) : __builtin_amdgcn_exp2f((float)(128 - iq - e) * l2b);
#pragma unroll
            for (int nt = 0; nt < 8; ++nt) {
                f32x4 t = (f32x4){0.f, 0.f, 0.f, 0.f};
#pragma unroll
                for (int ks = 0; ks < 4; ++ks) { const bf16x8 sf = *(const LAS bf16x8*)(St + ((nt * 16 + r) * TS + ks * 32 + kq * 8) * 2); t = mfma16(qf[ks], sf, t); }
#pragma unroll
                for (int e = 0; e < 4; ++e) oi[nt][e] += cr[e] * t[e];
                asm volatile("" ::: "memory");
            }
        }
        float ss[4];
#pragma unroll
        for (int e = 0; e < 4; ++e) { float s = 0.f;
#pragma unroll
            for (int nt = 0; nt < 8; ++nt) s += oi[nt][e] * oi[nt][e];
            s += __shfl_xor(s, 1); s += __shfl_xor(s, 2); s += __shfl_xor(s, 4); s += __shfl_xor(s, 8);
            ss[e] = rsqrtf(s * (1.0f / 128.0f) + EPS); }
#pragma unroll
        for (int nt = 0; nt < 8; ++nt)
#pragma unroll
            for (int e = 0; e < 4; ++e) *(LAS bf16*)(Pt + ((16 * wave + 4 * kq + e) * TS + nt * 16 + r) * 2) = (bf16)(pk2(oi[nt][e] * ss[e], 0.f) & 0xffffu);
        asm volatile("s_waitcnt lgkmcnt(0)" ::: "memory");
        { const int ln = kq * 16 + r, rw = ln >> 2, c4 = ln & 3, lrow = 16 * wave + rw; const float* rg = a.in[11] + h * 128 + c4 * 32;
#pragma unroll
            for (int k = 0; k < 4; ++k) { const v4u o8 = *(const LAS v4u*)(Pt + (lrow * TS + c4 * 32 + k * 8) * 2); const v4u g8 = pg_[k];
                const f32x4 r0 = *(const f32x4*)(rg + k * 8), r1 = *(const f32x4*)(rg + k * 8 + 4); const float rgv[8] = {r0.x, r0.y, r0.z, r0.w, r1.x, r1.y, r1.z, r1.w};
                v4u y;
#pragma unroll
                for (int w = 0; w < 4; ++w) { const float g0 = bflo(g8[w]), g1 = bfhi(g8[w]);
                    y[w] = pk2(g0 * pg8::fast_sigmoid(g0) * bflo(o8[w]) * rgv[2 * w], g1 * pg8::fast_sigmoid(g1) * bfhi(o8[w]) * rgv[2 * w + 1]); }
                *(v4u*)(YB + pg8::tiled_off(row0 + lrow, h * 128 + c4 * 32 + k * 8, D)) = y; }
            const int un = u + gridDim.x; if (un < 1280) { const bf16* gp = P + (size_t)((un >> 2) * 128 + lrow) * NAB + 1536 + (un & 3) * 128 + c4 * 32;
#pragma unroll
                for (int k = 0; k < 4; ++k) pg_[k] = *(const v4u*)(gp + k * 8); } }
    }
#endif
#ifndef NO_CONV
    {
        const float* cw = a.in[12]; const float* cbv = a.in[13];
        const int NT = gridDim.x * NTHREADS, gt = blockIdx.x * NTHREADS + tid0, c0 = (gt & 63) * 8;
        float w0[8], w1[8], w2[8], bb[8];
#pragma unroll
        for (int q = 0; q < 2; ++q) { const f32x4 t0 = *(const f32x4*)(cw + c0 + 4 * q), t1 = *(const f32x4*)(cw + 512 + c0 + 4 * q), t2 = *(const f32x4*)(cw + 1024 + c0 + 4 * q), t3 = *(const f32x4*)(cbv + c0 + 4 * q);
#pragma unroll
            for (int j = 0; j < 4; ++j) { w0[4 * q + j] = t0[j]; w1[4 * q + j] = t1[j]; w2[4 * q + j] = t2[j]; bb[4 * q + j] = t3[j]; } }
        for (int it = gt; it < (M / 4) * 64; it += NT) {
            const int m0 = (it >> 6) * 4;
            const int slen = m0 < MCTX ? 256 : 4096, pos0 = m0 < MCTX ? (m0 & 255) : ((m0 - MCTX) & 4095);
            const bf16* Pm = P + (size_t)m0 * NAB;
            v4u cg[6], xc[6], bg[4];
#pragma unroll
            for (int q = 0; q < 6; ++q) { const bool ok = (q == 0) ? (pos0 > 0) : ((q == 5) ? (pos0 + 4 < slen) : true);
                if (ok) { cg[q] = *(const v4u*)(Pm + (ptrdiff_t)(q - 1) * NAB + 2560 + c0); xc[q] = *(const v4u*)(Pm + (ptrdiff_t)(q - 1) * NAB + 3072 + c0); } else { cg[q] = (v4u){0u, 0u, 0u, 0u}; xc[q] = cg[q]; } }
#pragma unroll
            for (int q = 0; q < 4; ++q) bg[q] = *(const v4u*)(Pm + (size_t)q * NAB + 2048 + c0);
            float z[6][8];
#pragma unroll
            for (int q = 0; q < 6; ++q)
#pragma unroll
                for (int w = 0; w < 4; ++w) { z[q][2 * w] = bflo(cg[q][w]) * bflo(xc[q][w]); z[q][2 * w + 1] = bfhi(cg[q][w]) * bfhi(xc[q][w]); }
#pragma unroll
            for (int q = 0; q < 4; ++q) { v4u y;
#pragma unroll
                for (int w = 0; w < 4; ++w) {
                    const float y0 = bflo(bg[q][w]) * (w0[2 * w] * z[q][2 * w] + w1[2 * w] * z[q + 1][2 * w] + w2[2 * w] * z[q + 2][2 * w] + bb[2 * w]);
                    const float y1 = bfhi(bg[q][w]) * (w0[2 * w + 1] * z[q][2 * w + 1] + w1[2 * w + 1] * z[q + 1][2 * w + 1] + w2[2 * w + 1] * z[q + 2][2 * w + 1] + bb[2 * w + 1]);
                    y[w] = pk2(y0, y1); }
                *(v4u*)(YB + pg8::tiled_off(m0 + q, 512 + c0, D)) = y; }
        }
    }
#endif
}

__device__ __forceinline__ void spatial_phase(const Args& a, ldsp lds, int tid0, int lane, int wave) {
    const bf16* Z = (const bf16*)(a.ws + WS_P); bf16* YB = (bf16*)(a.ws + WS_YB); const float* vsq = (const float*)(a.ws + WS_VSQ);
    const float* w_s = a.in[17]; const float* b_s = a.in[18]; const float* vg = a.in[16];
    const ldsp At = lds, Vt = lds + TILE_B; LAS float* rs = (LAS float*)(lds + TILE_B + 128 * VS * 2);
    const int r0 = lane & 15, kq0 = lane >> 4;
    for (int u = blockIdx.x; u < 1280; u += gridDim.x) {
        const int cidx = u >> 2, g = u & 3, row0 = cidx * 128;
        int tid = tid0, r = r0, kq = kq0; asm volatile("" : "+v"(tid), "+v"(r), "+v"(kq));
        __syncthreads();
        if (tid < 128) { const f32x4* vp = (const f32x4*)(vsq + (size_t)(row0 + tid) * 16); const f32x4 s0 = vp[0], s1 = vp[1], s2 = vp[2], s3 = vp[3];
            const float s = ((s0.x + s0.y) + (s0.z + s0.w)) + ((s1.x + s1.y) + (s1.z + s1.w)) + ((s2.x + s2.y) + (s2.z + s2.w)) + ((s3.x + s3.y) + (s3.z + s3.w));
            rs[tid] = rsqrtf(s * (1.0f / 1024.0f) + EPS); }
#pragma unroll
        for (int rep = 0; rep < 8; ++rep) { const int it = tid + rep * NTHREADS, q = it >> 5, c = it & 31;
            *(LAS v4u*)(Vt + (q * VS + c * 8) * 2) = *(const v4u*)(Z + (size_t)(row0 + q) * NC + 1024 + g * 256 + c * 8); }
        __syncthreads();
#pragma unroll
        for (int rep = 0; rep < 4; ++rep) { const int it = tid + rep * NTHREADS, p = it >> 4, c = it & 15;
            const f32x4 w0 = *(const f32x4*)(w_s + (size_t)(g * 128 + p) * 128 + c * 8), w1 = *(const f32x4*)(w_s + (size_t)(g * 128 + p) * 128 + c * 8 + 4);
            const LAS float* rq = rs + c * 8;
            v4u o; o.x = pk2(w0.x * rq[0], w0.y * rq[1]); o.y = pk2(w0.z * rq[2], w0.w * rq[3]); o.z = pk2(w1.x * rq[4], w1.y * rq[5]); o.w = pk2(w1.z * rq[6], w1.w * rq[7]);
            *(LAS v4u*)(At + (p * TS + c * 8) * 2) = o; }
        __syncthreads();
        f32x4 acc[2][8];
#pragma unroll
        for (int n2 = 0; n2 < 2; ++n2)
#pragma unroll
            for (int mt = 0; mt < 8; ++mt) acc[n2][mt] = (f32x4){0.f, 0.f, 0.f, 0.f};
#pragma unroll
        for (int ks = 0; ks < 4; ++ks) { const int q0 = ks * 32 + kq * 8 + (r >> 2);
            const bf16x8 va0 = tr_frag(Vt + (q0 * VS + 32 * wave + 4 * (r & 3)) * 2, 8 * VS), va1 = tr_frag(Vt + (q0 * VS + 32 * wave + 16 + 4 * (r & 3)) * 2, 8 * VS);
#pragma unroll
            for (int mt = 0; mt < 8; ++mt) { const bf16x8 wf = *(const LAS bf16x8*)(At + ((mt * 16 + r) * TS + ks * 32 + kq * 8) * 2);
                acc[0][mt] = mfma16(va0, wf, acc[0][mt]); acc[1][mt] = mfma16(va1, wf, acc[1][mt]); } }
#pragma unroll
        for (int n2 = 0; n2 < 2; ++n2) { const int gch = g * 256 + 32 * wave + 16 * n2 + 4 * kq; const f32x4 vg4 = *(const f32x4*)(vg + gch);
#pragma unroll
            for (int mt = 0; mt < 8; ++mt) { const int p = mt * 16 + r; const float bsp = b_s[g * 128 + p];
                const v2u uu = *(const v2u*)(Z + (size_t)(row0 + p) * NC + gch);
                const float s0 = acc[n2][mt][0] * vg4.x + bsp, s1 = acc[n2][mt][1] * vg4.y + bsp, s2 = acc[n2][mt][2] * vg4.z + bsp, s3 = acc[n2][mt][3] * vg4.w + bsp;
                v2u y; y.x = pk2(bflo(uu.x) * s0, bfhi(uu.x) * s1); y.y = pk2(bflo(uu.y) * s2, bfhi(uu.y) * s3);
                *(v2u*)(YB + pg8::tiled_off(row0 + p, gch, D)) = y; } }
    }
}

__device__ __forceinline__ void shw_phase(const Args& a, int lane, int rw_lo, int rw_hi, int gw, int NGW) {
    unsigned char* ws = a.ws; const float* mod0 = (const float*)(ws + WS_MOD); const float* mod1 = mod0 + NCOND * MODW; float* shw = (float*)(ws + WS_SHW);
    for (int rw = rw_lo + gw; rw < rw_hi; rw += NGW) {
        const bf16* wrow; const float* sh; float* dst; int nb, n;
        if (rw < NGU) { n = rw; wrow = (const bf16*)(ws + WS_WGU); sh = mod0 + 3072; dst = shw; nb = NGU; }
        else if (rw < NGU + NC) { n = rw - NGU; wrow = (const bf16*)(ws + WS_WINC); sh = mod1; dst = shw + NCOND * NGU; nb = NC; }
        else { n = rw - NGU - NC; wrow = (const bf16*)(ws + WS_WGU) + (size_t)NGU * 1024; sh = mod1 + 3072; dst = shw + NCOND * (NGU + NC); nb = NGU; }
        const v4u w0 = *(const v4u*)(wrow + pg8::tiled_off_b(n, lane * 16, 1024)), w1 = *(const v4u*)(wrow + pg8::tiled_off_b(n, lane * 16 + 8, 1024));
        float wf[16];
#pragma unroll
        for (int q = 0; q < 4; ++q) { wf[2 * q] = bflo(w0[q]); wf[2 * q + 1] = bfhi(w0[q]); wf[8 + 2 * q] = bflo(w1[q]); wf[8 + 2 * q + 1] = bfhi(w1[q]); }
#pragma unroll
        for (int cb = 0; cb < NCOND; ++cb) { const f32x4* sp = (const f32x4*)(sh + (size_t)cb * MODW + lane * 16); float s = 0.f;
#pragma unroll
            for (int q = 0; q < 4; ++q) { const f32x4 t = sp[q]; s += (t.x * wf[4 * q] + t.y * wf[4 * q + 1]) + (t.z * wf[4 * q + 2] + t.w * wf[4 * q + 3]); }
            s = wave_sum(s); if (lane == 0) dst[(size_t)cb * nb + n] = s; }
    }
}

__device__ __forceinline__ void fn_row(const v4u x0, const v4u x1, float* yrow, const float* gn, int lane) {
    float v[16];
#pragma unroll
    for (int q = 0; q < 4; ++q) { v[2 * q] = bflo(x0[q]); v[2 * q + 1] = bfhi(x0[q]); v[8 + 2 * q] = bflo(x1[q]); v[8 + 2 * q + 1] = bfhi(x1[q]); }
    float s = 0.f;
#pragma unroll
    for (int q = 0; q < 16; ++q) s += v[q] * v[q];
    const float rstd = rsqrtf(wave_sum(s) * (1.0f / D) + EPS);
#pragma unroll
    for (int c = 0; c < 2; ++c) { const int col = 8 * lane + 512 * c; const f32x4 g0 = *(const f32x4*)(gn + col), g1 = *(const f32x4*)(gn + col + 4);
        *(f32x4*)(yrow + col) = (f32x4){v[8 * c] * rstd * g0.x, v[8 * c + 1] * rstd * g0.y, v[8 * c + 2] * rstd * g0.z, v[8 * c + 3] * rstd * g0.w};
        *(f32x4*)(yrow + col + 4) = (f32x4){v[8 * c + 4] * rstd * g1.x, v[8 * c + 5] * rstd * g1.y, v[8 * c + 6] * rstd * g1.z, v[8 * c + 7] * rstd * g1.w}; }
}
__device__ __forceinline__ void final_norm_direct(const bf16* src, int src_row0, float* y, const float* gn, int m_lo, int m_hi, int lane, int wave) {
    const int gw = blockIdx.x * NWAVES + wave, NGW = gridDim.x * NWAVES;
    for (int m = m_lo + gw; m < m_hi; m += 2 * NGW) { const int mb = m + NGW; const bool two = mb < m_hi;
        const bf16* xr = src + (size_t)(m - src_row0) * D + 8 * lane; const bf16* xs = src + (size_t)((two ? mb : m) - src_row0) * D + 8 * lane;
        const v4u x0 = *(const v4u*)xr, x1 = *(const v4u*)(xr + 512), z0 = *(const v4u*)xs, z1 = *(const v4u*)(xs + 512);
        fn_row(x0, x1, y + (size_t)m * D, gn, lane); if (two) fn_row(z0, z1, y + (size_t)mb * D, gn, lane); }
}
constexpr int FN_SPLIT = M / 2;
#define XB_TMO      128
#define XB_XCNT(j)  (256  + 64 * (j))
#define XB_XSUB(j)  (1280 + 64 * (j))
#define XB_XGEN(j)  (2304 + 64 * (j))
#define XB_TOP      3328
#define XB_TOPGEN   3392
#define XCD_BAR_WORDS 3456
#define XB_SPIN_CAP (1u << 18)

__device__ __forceinline__ unsigned xb_ld(unsigned* p)              { return __hip_atomic_load(p, __ATOMIC_RELAXED, __HIP_MEMORY_SCOPE_AGENT); }
__device__ __forceinline__ unsigned xb_add(unsigned* p, unsigned v) { return __hip_atomic_fetch_add(p, v, __ATOMIC_RELAXED, __HIP_MEMORY_SCOPE_AGENT); }
__device__ __forceinline__ unsigned xb_xcc_id() { return (unsigned)__builtin_amdgcn_s_getreg((3 << 11) | 20) & 0xFu; }
#define XB_SPIN(cond, bar) do { unsigned _sp = 0; while (cond) { __builtin_amdgcn_s_sleep(1); \
    if ((++_sp & 255u) == 0u) { if (xb_ld(&(bar)[XB_TMO])) break; if (_sp > XB_SPIN_CAP) { atomicAdd(&(bar)[XB_TMO], 1u); break; } } } } while (0)

struct XcdBarrier {
    unsigned* bar; unsigned x;
    volatile LAS unsigned* st;
};

__device__ __forceinline__ XcdBarrier xcd_barrier_post(unsigned* bar, volatile LAS unsigned* st) {
    XcdBarrier b; b.bar = bar; b.x = xb_xcc_id(); b.st = st;
    if (threadIdx.x == 0) (void)xb_add(&bar[XB_XCNT(b.x)], 1u);
    return b;
}
__device__ __forceinline__ void xcd_barrier_complete(unsigned* bar, unsigned x, unsigned& nloc, unsigned& nx) {
    const unsigned G = gridDim.x * gridDim.y * gridDim.z;
    unsigned sum, cnt, mine, sp = 0u;
    for (;;) {
        sum = 0u; cnt = 0u; mine = 0u;
#pragma unroll
        for (unsigned j = 0; j < 16; ++j) { const unsigned c = xb_ld(&bar[XB_XCNT(j)]); sum += c; cnt += (c > 0u) ? 1u : 0u; mine = (j == x) ? c : mine; }
        if (sum == G) break;
        __builtin_amdgcn_s_sleep(1);
        if ((++sp & 255u) == 0u) { if (xb_ld(&bar[XB_TMO])) break; if (sp > XB_SPIN_CAP) { atomicAdd(&bar[XB_TMO], 1u); break; } }
    }
    nloc = mine > 0u ? mine : 1u; nx = cnt > 0u ? cnt : 1u;
}

__device__ __forceinline__ void xcd_barrier(const XcdBarrier& b) {
    asm volatile("s_waitcnt vmcnt(0)" ::: "memory");
    __syncthreads();
    if (threadIdx.x == 0) {
        unsigned* bar = b.bar;
        __builtin_amdgcn_s_waitcnt(0);
        unsigned nloc = b.st[0], nx = b.st[1];
        if (nloc == 0u) { xcd_barrier_complete(bar, b.x, nloc, nx); b.st[0] = nloc; b.st[1] = nx; }
        const unsigned old = xb_add(&bar[XB_XSUB(b.x)], 1u);
        const unsigned gen = old / nloc;
        if (old + 1u == (gen + 1u) * nloc) {
            __builtin_amdgcn_fence(__ATOMIC_RELEASE, "agent");
            asm volatile("s_waitcnt vmcnt(0)" ::: "memory");
            const unsigned og = xb_add(&bar[XB_TOP], 1u);
            const unsigned tg = og / nx;
            if (og + 1u == (tg + 1u) * nx) xb_add(&bar[XB_TOPGEN], 1u);
            else XB_SPIN(xb_ld(&bar[XB_TOPGEN]) == tg, bar);
            __builtin_amdgcn_fence(__ATOMIC_ACQUIRE, "agent");
            xb_add(&bar[XB_XGEN(b.x)], 1u);
            asm volatile("s_waitcnt vmcnt(0)" ::: "memory");
        } else {
            XB_SPIN(xb_ld(&bar[XB_XGEN(b.x)]) == gen, bar);
            __builtin_amdgcn_fence(__ATOMIC_ACQUIRE, "agent");
            asm volatile("s_waitcnt vmcnt(0)" ::: "memory");
        }
    }
    __syncthreads();
}

__global__ void __launch_bounds__(NTHREADS, 2) mega_fwd(Args a) {
    extern __shared__ __attribute__((aligned(16))) unsigned char lds_raw[];
    const ldsp lds = (ldsp)lds_raw;
    const int tid = threadIdx.x, lane = tid & 63, wave = __builtin_amdgcn_readfirstlane(tid >> 6);
    unsigned char* ws = a.ws;
    float* mod0 = (float*)(ws + WS_MOD); float* mod1 = mod0 + NCOND * MODW;
    bf16* HB = (bf16*)(ws + WS_HB); bf16* YB = (bf16*)(ws + WS_YB); bf16* PB = (bf16*)(ws + WS_P);
    const int G = gridDim.x, bx = blockIdx.x;
#if ONE_LAUNCH
    volatile LAS unsigned* misc = (volatile LAS unsigned*)(lds + MISC_OFF);
    if (tid < 16) misc[tid] = 0u;
    __syncthreads();
    const XcdBarrier xbar = xcd_barrier_post((unsigned*)(ws + WS_BAR), misc);
#endif
#define IN(k) (((PH_MASK >> (k)) & 1) && a.ph_lo <= (k) && (k) < a.ph_hi)
#define INN(k) (a.ph_lo <= (k) && (k) < a.ph_hi)
#if ONE_LAUNCH
#define SEAM(k) do { if (INN(k) && INN((k) + 1)) xcd_barrier(xbar); } while (0)
#else
#define SEAM(k) do { } while (0)
#endif
#define STAGGER(ticks) do { if (ONE_LAUNCH && (ticks) > 0) { const unsigned long long t0_ = __builtin_amdgcn_s_memrealtime(); const unsigned long long dl_ = (unsigned long long)(((bx >> 3) & 31) * (ticks)) >> 5; \
        while (__builtin_amdgcn_s_memrealtime() - t0_ < dl_) __builtin_amdgcn_s_sleep(16); } } while (0)
#define GEMM(EpiT, Aop, Bop, Nn, Kk, Eobj) do { pg8::Gemm g_{(const pg8::bf16_t*)(Aop), (const pg8::bf16_t*)(Bop), M, (Nn), (Kk)}; pg8::StaticOrder S_; S_.init(M, (Nn), G, bx); \
        pg8::gemm_phase<EpiT, pg8::StaticOrder, true, true>(lds, g_, S_, (Eobj)); } while (0)

#if ONE_LAUNCH
    if (a.ph_lo < 0) cg::this_grid().sync();
#endif
    if (IN(0)) p0_prologue(a, lds, tid, lane, wave);
    SEAM(0);
    if (IN(1)) { norm_pass<true>(a, a.in[7], mod0, 0, 1024, HB, lane, wave); if (G != 256) shw_phase(a, lane, 0, 2 * NGU + NC, bx * NWAVES + wave, G * NWAVES); }
    SEAM(1);
    if (IN(2)) { pg8::EpiStoreBf16 E{PB, NAB}; GEMM(pg8::EpiStoreBf16, HB, ws + WS_WAB, NAB, 1024, E);
        if (G == 256 && bx >= 192) convert_range(a, lds, CONV_FIRST, CONV_EARLY, (bx - 192) * NWAVES + wave, 64 * NWAVES, lane, wave); }
    SEAM(2);
    if (IN(3)) r1_phase(a, lds, tid, lane, wave);
    SEAM(3);
    if (IN(4)) r2_phase(a, tid);
    SEAM(4);
    if (IN(5)) r3_phase(a, lds, tid, lane, wave);
    SEAM(5);
    float* rsq = (float*)(ws + WS_RSQ); const float* shw = (const float*)(ws + WS_SHW);
    bf16* XB0 = (bf16*)a.out; bf16* XB1 = XB0 + (size_t)M * D;
    typedef pg8::EpiResidB<true, true> EpiR0; typedef pg8::EpiResidB<false, true> EpiR1; typedef pg8::EpiResidB<false, false> EpiR2;
    if (IN(6)) { EpiR0 E{a.in[0], a.in[1], nullptr, XB0, mod0 + 2048, HB, a.in[8], mod0 + 4096, rsq}; GEMM(EpiR0, YB, ws + WS_WOAB, 1024, 1024, E);
        if (G == 256 && bx >= 128) { shw_phase(a, lane, 0, NGU, (bx - 128) * NWAVES + wave, 128 * NWAVES); convert_range(a, lds, CONV_EARLY, CONV_ALL, (bx - 128) * NWAVES + wave, 128 * NWAVES, lane, wave); } }
    SEAM(6);
    if (IN(8)) { pg8::EpiSwiglu E{PB, FF, rsq, shw, NGU}; GEMM(pg8::EpiSwiglu, HB, ws + WS_WGU, NGU, 1024, E); }
    SEAM(8);
    if (IN(9)) { EpiR1 E{nullptr, nullptr, XB0, XB1, mod0 + 5120, HB, a.in[7] + D, mod1 + 1024, rsq}; GEMM(EpiR1, PB, ws + WS_WDN, 1024, FF, E);
        if (G == 256 && bx >= 128) shw_phase(a, lane, NGU, 2 * NGU + NC, (bx - 128) * NWAVES + wave, 128 * NWAVES); }
    SEAM(9);
    if (IN(11)) { pg8::EpiGeluSq E{PB, NC, (float*)(ws + WS_VSQ), 4, rsq, shw + NCOND * NGU, NC}; GEMM(pg8::EpiGeluSq, HB, ws + WS_WINC, NC, 1024, E); }
    SEAM(11);
    if (IN(12)) spatial_phase(a, lds, tid, lane, wave);
    SEAM(12);
    if (IN(13)) { EpiR1 E{nullptr, nullptr, XB1, XB0, mod1 + 2048, HB, a.in[8] + D, mod1 + 4096, rsq}; GEMM(EpiR1, YB, ws + WS_WOC, 1024, 1024, E); }
    SEAM(13);
    if (IN(15)) { pg8::EpiSwiglu E{PB, FF, rsq, shw + NCOND * (NGU + NC), NGU}; GEMM(pg8::EpiSwiglu, HB, ws + WS_WGU + (size_t)NGU * 1024 * 2, NGU, 1024, E); }
    SEAM(15);
    if (IN(16)) { EpiR2 E{nullptr, nullptr, XB0, HB, mod1 + 5120, nullptr, nullptr, nullptr, nullptr};
    GEMM(EpiR2, PB, ws + WS_WDN + (size_t)1024 * FF * 2, 1024, FF, E); }
    SEAM(16);
    if (IN(17)) final_norm_direct(HB, 0, a.out, a.in[23], 0, M, lane, wave);
#undef IN
#undef STAGGER
#undef SEAM
#undef GEMM
}

extern "C" void kernel_launch(void* const* d_in, const int* in_sizes, int n_in, void* d_out, int out_size, void* d_ws, size_t ws_size, hipStream_t stream) {
    static int grid = 0;
    if (grid == 0) {
        if (n_in != 24 || ws_size < WS_END) { fprintf(stderr, "kernel_launch: unexpected n_in %d / ws_size %zu\n", n_in, ws_size); grid = -1; return; }
        int dev = 0, cus = 0;
        if (hipGetDevice(&dev) != hipSuccess || hipDeviceGetAttribute(&cus, hipDeviceAttributeMultiprocessorCount, dev) != hipSuccess) { grid = -1; return; }
        if (hipFuncSetAttribute((const void*)mega_fwd, hipFuncAttributeMaxDynamicSharedMemorySize, LDS_BYTES) != hipSuccess) { fprintf(stderr, "kernel_launch: hipFuncSetAttribute failed\n"); grid = -1; return; }
        (void)hipGetLastError();
        grid = cus;
    }
    if (grid < 0) return;
    Args a{};
    for (int i = 0; i < 24; ++i) a.in[i] = (const float*)d_in[i];
    a.out = (float*)d_out; a.ws = (unsigned char*)d_ws;
#if ONE_LAUNCH
    if (hipMemsetAsync((char*)d_ws + WS_BAR, 0, XCD_BAR_WORDS * 4, stream) != hipSuccess) { fprintf(stderr, "kernel_launch: hipMemsetAsync failed\n"); return; }
    a.ph_lo = 0; a.ph_hi = N_PHASES;
    void* args[] = {&a};
    hipError_t e = hipLaunchCooperativeKernel((const void*)mega_fwd, dim3(grid), dim3(NTHREADS), args, LDS_BYTES, stream);
    if (e != hipSuccess) fprintf(stderr, "cooperative launch failed: %s (grid %d)\n", hipGetErrorString(e), grid);
#else
    for (int p = 0; p < N_PHASES; ++p) { a.ph_lo = p; a.ph_hi = p + 1; hipLaunchKernelGGL(mega_fwd, dim3(grid), dim3(NTHREADS), LDS_BYTES, stream, a); }
#endif
}
```

```cpp
#include <hip/hip_runtime.h>
#include <hip/hip_cooperative_groups.h>
#include <cstdio>
#include <cstdint>
namespace cg = cooperative_groups;
#ifndef PG8_AUX_A
#define PG8_AUX_A 0
#endif
#ifndef PG8_AUX_B
#define PG8_AUX_B 0
#endif
#ifndef PG8_PFD
#define PG8_PFD 5
#endif
namespace pg8 {
#define PG8_LAS __attribute__((address_space(3)))
typedef unsigned short bf16_t;
typedef short bf16x8 __attribute__((ext_vector_type(8)));
typedef float f32x4 __attribute__((ext_vector_type(4)));
typedef unsigned u32x4 __attribute__((ext_vector_type(4)));
typedef unsigned u32x2 __attribute__((ext_vector_type(2)));
constexpr int BM = 256, BK = 64, HALF = 128, HTB = HALF * BK * 2  , STAGE_BYTES = 8 * HTB, NXCD = 8, WGM = 4;

__host__ __device__ __forceinline__ int lds_byte(int r, int c) { const int st = (r >> 4) * 2 + (c >> 5), rr = r & 15, cc = c & 31, ob = rr * 64 + cc * 2; return st * 1024 + (ob ^ (((ob >> 9) & 1) << 5)); }
__host__ __device__ __forceinline__ void stage_rc(int b, int& R, int& C) { const int st = b / 1024, sb = b % 1024, swz = sb ^ (((sb >> 9) & 1) << 5); R = (st >> 1) * 16 + swz / 64; C = (st & 1) * 32 + (swz % 64) / 2; }
__host__ __device__ __forceinline__ int perm32(int rho) { const int n = rho >> 4, i = rho & 15; return 8 * (i >> 2) + 4 * n + (i & 3); }

__host__ __device__ __forceinline__ int invperm32(int x) { return ((x >> 2) & 1) * 16 + (x >> 3) * 4 + (x & 3); }
__host__ __device__ __forceinline__ size_t tiled_off(int m, int k, int K) { return ((((size_t)(m >> 8) * (size_t)(K >> 6)) + (size_t)(k >> 6)) << 14) + (size_t)(((m >> 7) & 1) << 13) + (size_t)(lds_byte(m & 127, k & 63) >> 1); }
__host__ __device__ __forceinline__ size_t tiled_off_b(int n, int k, int K) { const int r = n & 127, R = (r & ~31) + invperm32(r & 31); return ((((size_t)(n >> 8) * (size_t)(K >> 6)) + (size_t)(k >> 6)) << 14) + (size_t)(((n >> 7) & 1) << 13) + (size_t)(lds_byte(R, k & 63) >> 1); }
struct Unit { int pm, pn; };
struct Gemm { const bf16_t* A; const bf16_t* Bt; int M, N, K; };

struct StaticOrder {
    int nM, nN, nwg, G, c;
    __host__ __device__ void init(int M, int N, int G_, int c_) { nM = M / BM; nN = N / BM; nwg = nM * nN; G = G_; c = c_; }
    __host__ __device__ bool next(int i, Unit& u) const {
        const long L = (long)i * G + c; if (L >= nwg) return false;
        int wgid = (int)L; { const int q = nwg / NXCD, r = nwg % NXCD, xcd = wgid % NXCD, off = wgid / NXCD; wgid = (xcd < r ? xcd * (q + 1) : r * (q + 1) + (xcd - r) * q) + off; }
        const int nig = WGM * nN, gid = wgid / nig, fm = gid * WGM, gsz = (nM - fm) < WGM ? (nM - fm) : WGM;
        u.pm = fm + ((wgid % nig) % gsz); u.pn = (wgid % nig) / gsz; return true;
    }
    __device__ __forceinline__ void a_ready(const Unit&) const {}
    __device__ __forceinline__ void done(const Unit&) const {}
};

typedef float f32x2_cv __attribute__((ext_vector_type(2))); typedef __bf16 bf16x2_cv __attribute__((ext_vector_type(2)));
__device__ __forceinline__ unsigned cvt_pk_bf16(float lo, float hi) { const f32x2_cv v = {lo, hi}; const bf16x2_cv b = __builtin_convertvector(v, bf16x2_cv); return __builtin_bit_cast(unsigned, b); }
typedef float f32x2 __attribute__((ext_vector_type(2)));
__device__ __forceinline__ float fast_sigmoid(float x) { return __builtin_amdgcn_rcpf(1.0f + __builtin_amdgcn_exp2f(-1.4426950408889634f * x)); }
struct EpiStoreBf16 {
    static constexpr bool PERM = true, AFTER_DRAIN = false;
    bf16_t* O; int ldc;
    __device__ __forceinline__ void operator()(const f32x4 (&acc)[2][2][4][2], const Unit& u, int wr, int wc, int fr, int fq) const {
        const int row0 = u.pm * BM + wr * 64 + fr, col0 = u.pn * BM + wc * 32 + 8 * fq;
#pragma unroll
        for (int ai = 0; ai < 2; ++ai)
#pragma unroll
            for (int m = 0; m < 4; ++m) { bf16_t* rowp = O + (size_t)(row0 + ai * HALF + m * 16) * ldc + col0;
#pragma unroll
                for (int bj = 0; bj < 2; ++bj) { const f32x4 v0 = acc[ai][bj][m][0], v1 = acc[ai][bj][m][1];
                    u32x4 w; w.x = cvt_pk_bf16(v0[0], v0[1]); w.y = cvt_pk_bf16(v0[2], v0[3]); w.z = cvt_pk_bf16(v1[0], v1[1]); w.w = cvt_pk_bf16(v1[2], v1[3]);
                    *(u32x4*)(rowp + bj * HALF) = w; } }
    }
};
__device__ __forceinline__ void load_rstd(const float* rsq, int row0, int fq, float (&rstd)[2][4]) {
#pragma unroll
    for (int ai = 0; ai < 2; ++ai)
#pragma unroll
        for (int m = 0; m < 4; ++m) { const f32x4 p = *(const f32x4*)(rsq + (size_t)(row0 + ai * HALF + m * 16) * 16 + 4 * fq); float s = (p[0] + p[1]) + (p[2] + p[3]);
            s += __shfl_xor(s, 16); s += __shfl_xor(s, 32); rstd[ai][m] = rsqrtf(s * (1.0f / 1024.0f) + 1e-6f); }
}
struct EpiGeluSq {
    static constexpr bool PERM = true, AFTER_DRAIN = false;
    bf16_t* O; int ldc; float* vsq; int pn_v; const float* rsq; const float* bias; int nbias;
    __device__ __forceinline__ void operator()(const f32x4 (&acc)[2][2][4][2], const Unit& u, int wr, int wc, int fr, int fq) const {
        const int row0 = u.pm * BM + wr * 64 + fr, col0 = u.pn * BM + wc * 32 + 8 * fq;
        const int cb = u.pm < 32 ? 0 : 1 + ((u.pm - 32) >> 4);
        float rstd[2][4]; load_rstd(rsq, row0, fq, rstd);
        f32x4 bv[2][2];
#pragma unroll
        for (int bj = 0; bj < 2; ++bj)
#pragma unroll
            for (int n = 0; n < 2; ++n) bv[bj][n] = *(const f32x4*)(bias + (size_t)cb * nbias + col0 + bj * HALF + 4 * n);
#pragma unroll
        for (int ai = 0; ai < 2; ++ai)
#pragma unroll
            for (int m = 0; m < 4; ++m) { const int row = row0 + ai * HALF + m * 16; bf16_t* rowp = O + (size_t)row * ldc + col0; float ss = 0.f;
#pragma unroll
                for (int bj = 0; bj < 2; ++bj) { f32x4 v[2];
#pragma unroll
                    for (int n = 0; n < 2; ++n)
#pragma unroll
                        for (int j = 0; j < 4; ++j) { const float x = acc[ai][bj][m][n][j] * rstd[ai][m] + bv[bj][n][j];
                            const float gl = x * __builtin_amdgcn_rcpf(1.0f + __builtin_amdgcn_exp2f(x * (x * x * -0.10294324f + -2.3022082f))); v[n][j] = gl; ss += gl * gl; }
                    u32x4 w; w.x = cvt_pk_bf16(v[0][0], v[0][1]); w.y = cvt_pk_bf16(v[0][2], v[0][3]); w.z = cvt_pk_bf16(v[1][0], v[1][1]); w.w = cvt_pk_bf16(v[1][2], v[1][3]);
                    *(u32x4*)(rowp + bj * HALF) = w; }
                ss += __shfl_xor(ss, 16); ss += __shfl_xor(ss, 32);
                if (u.pn >= pn_v && fq == 0) vsq[(size_t)row * 16 + (u.pn - pn_v) * 4 + wc] = ss; }
    }
};
struct EpiSwiglu {
    static constexpr bool PERM = true, AFTER_DRAIN = false;
    bf16_t* O; int ldc; const float* rsq; const float* bias; int nbias;
    __device__ __forceinline__ void operator()(const f32x4 (&acc)[2][2][4][2], const Unit& u, int wr, int wc, int fr, int fq) const {
        const int row0 = u.pm * BM + wr * 64 + fr, col0 = u.pn * HALF + wc * 32 + 8 * fq;
        const int cb = u.pm < 32 ? 0 : 1 + ((u.pm - 32) >> 4);
        float rstd[2][4]; load_rstd(rsq, row0, fq, rstd);
        f32x4 bv[2][2];
#pragma unroll
        for (int bj = 0; bj < 2; ++bj)
#pragma unroll
            for (int n = 0; n < 2; ++n) bv[bj][n] = *(const f32x4*)(bias + (size_t)cb * nbias + u.pn * BM + bj * HALF + wc * 32 + 8 * fq + 4 * n);
#pragma unroll
        for (int ai = 0; ai < 2; ++ai)
#pragma unroll
            for (int m = 0; m < 4; ++m) { bf16_t* rowp = O + tiled_off(row0 + ai * HALF + m * 16, col0, ldc); f32x4 v[2];
#pragma unroll
                for (int n = 0; n < 2; ++n)
#pragma unroll
                    for (int j = 0; j < 4; ++j) { const float g = acc[ai][0][m][n][j] * rstd[ai][m] + bv[0][n][j], up = acc[ai][1][m][n][j] * rstd[ai][m] + bv[1][n][j]; v[n][j] = g * fast_sigmoid(g) * up; }
                u32x4 w; w.x = cvt_pk_bf16(v[0][0], v[0][1]); w.y = cvt_pk_bf16(v[0][2], v[0][3]); w.z = cvt_pk_bf16(v[1][0], v[1][1]); w.w = cvt_pk_bf16(v[1][2], v[1][3]);
                *(u32x4*)rowp = w; }
    }
};
template <bool F32BASE, bool NORM> struct EpiResidB {
    static constexpr bool PERM = true, AFTER_DRAIN = false;
    const float* b0; const float* b1; const bf16_t* XI; bf16_t* XO; const float* gate; bf16_t* A; const float* gn; const float* sc; float* rsq;
    __device__ __forceinline__ void operator()(const f32x4 (&acc)[2][2][4][2], const Unit& u, int wr, int wc, int fr, int fq) const {
        const int cb = u.pm < 32 ? 0 : 1 + ((u.pm - 32) >> 4);
        const int row0 = u.pm * BM + wr * 64 + fr, col0 = u.pn * BM + wc * 32 + 8 * fq;
        const float* bf = u.pm < 32 ? b0 : b1 - (size_t)8192 * 1024;
        f32x4 gv[2][2], gm[2][2];
#pragma unroll
        for (int bj = 0; bj < 2; ++bj)
#pragma unroll
            for (int n = 0; n < 2; ++n) { const int c = col0 + bj * HALF + 4 * n; gv[bj][n] = *(const f32x4*)(gate + cb * 6144 + c);
                if (NORM) gm[bj][n] = *(const f32x4*)(gn + c) * (*(const f32x4*)(sc + cb * 6144 + c) + 1.0f); }
#pragma unroll
        for (int ai = 0; ai < 2; ++ai)
#pragma unroll
            for (int m = 0; m < 4; ++m) { const int row = row0 + ai * HALF + m * 16; float ss = 0.f;
#pragma unroll
                for (int bj = 0; bj < 2; ++bj) { const size_t off = (size_t)row * 1024 + col0 + bj * HALF; f32x4 x0, x1;
                    if (F32BASE) { x0 = *(const f32x4*)(bf + off); x1 = *(const f32x4*)(bf + off + 4); }
                    else { const u32x4 w = *(const u32x4*)(XI + off); x0 = (f32x4){__uint_as_float(w.x << 16), __uint_as_float(w.x & 0xffff0000u), __uint_as_float(w.y << 16), __uint_as_float(w.y & 0xffff0000u)};
                        x1 = (f32x4){__uint_as_float(w.z << 16), __uint_as_float(w.z & 0xffff0000u), __uint_as_float(w.w << 16), __uint_as_float(w.w & 0xffff0000u)}; }
                    x0 = x0 + gv[bj][0] * acc[ai][bj][m][0]; x1 = x1 + gv[bj][1] * acc[ai][bj][m][1];
                    u32x4 o; o.x = cvt_pk_bf16(x0[0], x0[1]); o.y = cvt_pk_bf16(x0[2], x0[3]); o.z = cvt_pk_bf16(x1[0], x1[1]); o.w = cvt_pk_bf16(x1[2], x1[3]);
                    *(u32x4*)(XO + off) = o;
                    if (NORM) { ss += ((x0[0] * x0[0] + x0[1] * x0[1]) + (x0[2] * x0[2] + x0[3] * x0[3])) + ((x1[0] * x1[0] + x1[1] * x1[1]) + (x1[2] * x1[2] + x1[3] * x1[3]));
                        const f32x4 a0 = x0 * gm[bj][0], a1 = x1 * gm[bj][1];
                        u32x4 q; q.x = cvt_pk_bf16(a0[0], a0[1]); q.y = cvt_pk_bf16(a0[2], a0[3]); q.z = cvt_pk_bf16(a1[0], a1[1]); q.w = cvt_pk_bf16(a1[2], a1[3]);
                        *(u32x4*)(A + tiled_off(row, col0 + bj * HALF, 1024)) = q; } }
                if (NORM) { ss += __shfl_xor(ss, 16); ss += __shfl_xor(ss, 32); if (fq == 0) rsq[(size_t)row * 16 + u.pn * 4 + wc] = ss; } }
    }
};
template <class Epi, class Sched, bool ALIGN_EPI = false, bool SP2 = false>
__device__ __forceinline__ void gemm_phase(PG8_LAS unsigned char* lds, const Gemm g, const Sched& S, const Epi& E) {
    const int tid = threadIdx.x, wid = __builtin_amdgcn_readfirstlane(tid >> 6), lane = tid & 63, wr = wid >> 2, wc = wid & 3, fr = lane & 15, fq = lane >> 4;
    const int K = g.K, nt = K / BK;
    unsigned voffA[2], voffB[2];
#pragma unroll
    for (int i = 0; i < 2; ++i) { voffA[i] = (unsigned)(tid * 16 + i * 8192); voffB[i] = voffA[i]; }
    const size_t kstep = (size_t)(BM * BK * 2);
    const size_t hstep = (size_t)HALF * BK * 2;
    const size_t tstep = (size_t)BM * K * 2;
    const unsigned ldsw = (unsigned)wid * 1024u;
    const int aoff = lds_byte(wr * 64 + fr, fq * 8), boff = lds_byte(wc * 32 + fr, fq * 8);
#define PG8_SA(b, h) (((b) * 2 + (h)) * HTB)
#define PG8_SB(b, h) ((4 + (b) * 2 + (h)) * HTB)
#define PG8_STAGE(bufoff, gbase, voff) do { _Pragma("unroll") for (int _i = 0; _i < 2; ++_i) { \
        if ((bufoff) >= 4 * HTB) __builtin_amdgcn_global_load_lds((const unsigned*)((const char*)(gbase) + (voff)[_i]), (PG8_LAS unsigned*)(lds + (bufoff) + ldsw + _i * 8192), 16, 0, PG8_AUX_B); \
        else __builtin_amdgcn_global_load_lds((const unsigned*)((const char*)(gbase) + (voff)[_i]), (PG8_LAS unsigned*)(lds + (bufoff) + ldsw + _i * 8192), 16, 0, PG8_AUX_A); } } while (0)
#define PG8_LDA(dst, b, h) do { _Pragma("unroll") for (int m = 0; m < 4; ++m) _Pragma("unroll") for (int k = 0; k < 2; ++k) dst[m][k] = *(const PG8_LAS bf16x8*)(lds + PG8_SA(b, h) + aoff + m * 2048 + k * 1024); } while (0)
#define PG8_LDB(dst, b, h) do { _Pragma("unroll") for (int n = 0; n < 2; ++n) _Pragma("unroll") for (int k = 0; k < 2; ++k) dst[n][k] = *(const PG8_LAS bf16x8*)(lds + PG8_SB(b, h) + boff + n * 2048 + k * 1024); } while (0)
#define PG8_MMA(ai, bj, At, Bt) do { __builtin_amdgcn_s_setprio(1); _Pragma("unroll") for (int m = 0; m < 4; ++m) _Pragma("unroll") for (int n = 0; n < 2; ++n) _Pragma("unroll") for (int k = 0; k < 2; ++k) \
        acc[ai][bj][m][n] = __builtin_amdgcn_mfma_f32_16x16x32_bf16(Bt[n][k], At[m][k], acc[ai][bj][m][n], 0, 0, 0); __builtin_amdgcn_s_setprio(0); } while (0)
#define PG8_WAIT_V(n) asm volatile("s_waitcnt vmcnt(" #n ")" ::: "memory")
#define PG8_WAIT_L(n) asm volatile("s_waitcnt lgkmcnt(" #n ")" ::: "memory")
#define PG8_BAR __builtin_amdgcn_s_barrier()
#define PG8_SCHED __builtin_amdgcn_sched_barrier(0)
    Unit cur, nxt; int ui = 0;
    if (!S.next(0, cur)) return;
    f32x4 acc[2][2][4][2];
#pragma unroll
    for (int a = 0; a < 2; ++a)
#pragma unroll
        for (int b = 0; b < 2; ++b)
#pragma unroll
            for (int m = 0; m < 4; ++m)
#pragma unroll
                for (int n = 0; n < 2; ++n) acc[a][b][m][n] = (f32x4){0.f, 0.f, 0.f, 0.f};
    bf16x8 At[4][2], B0[2][2], B1[2][2];
    const char* cA = (const char*)g.A + (size_t)cur.pm * tstep; const char* cB = (const char*)g.Bt + (size_t)cur.pn * tstep;
    S.a_ready(cur);
    if constexpr (SP2) {
        PG8_STAGE(PG8_SB(0, 0), cB, voffB); PG8_STAGE(PG8_SB(0, 1), cB + hstep, voffB); PG8_STAGE(PG8_SA(0, 0), cA, voffA); PG8_STAGE(PG8_SA(0, 1), cA + hstep, voffA);
        if (wr == 1) PG8_BAR;
        PG8_WAIT_V(2); PG8_BAR;
        PG8_STAGE(PG8_SB(1, 0), cB + kstep, voffB); PG8_STAGE(PG8_SA(1, 0), cA + kstep, voffA); PG8_STAGE(PG8_SB(1, 1), cB + hstep + kstep, voffB);
        PG8_WAIT_V(6); PG8_BAR;
    } else {
        PG8_STAGE(PG8_SB(0, 0), cB, voffB); PG8_STAGE(PG8_SA(0, 0), cA, voffA); PG8_STAGE(PG8_SB(0, 1), cB + hstep, voffB); PG8_STAGE(PG8_SA(0, 1), cA + hstep, voffA);
        if (wr == 1) PG8_BAR;
        PG8_WAIT_V(4); PG8_BAR;
        PG8_STAGE(PG8_SB(1, 0), cB + kstep, voffB); PG8_STAGE(PG8_SA(1, 0), cA + kstep, voffA); PG8_STAGE(PG8_SB(1, 1), cB + hstep + kstep, voffB);
        PG8_WAIT_V(6); PG8_BAR;
    }
    for (;;) {
        const bool has_next = S.next(ui + 1, nxt);
        const char* nA = has_next ? (const char*)g.A + (size_t)nxt.pm * tstep : cA; const char* nB = has_next ? (const char*)g.Bt + (size_t)nxt.pn * tstep : cB;
        for (int t = 0; t < nt; t += 2) {
            const bool last = (t == nt - 2);
            const char* a1 = cA + (size_t)(t + 1) * kstep;
            const char* a2 = last ? nA : cA + (size_t)(t + 2) * kstep; const char* b2 = last ? nB : cB + (size_t)(t + 2) * kstep;
            const char* a3 = a2 + kstep; const char* b3 = b2 + kstep;
            if (last && has_next) S.a_ready(nxt);
            if constexpr (SP2) {
            PG8_LDB(B0, 0, 0); PG8_LDB(B1, 0, 1); PG8_SCHED; PG8_LDA(At, 0, 0); PG8_STAGE(PG8_SA(1, 1), a1 + hstep, voffA);
            PG8_WAIT_V(8); PG8_WAIT_L(0); PG8_BAR; PG8_MMA(0, 0, At, B0); PG8_MMA(0, 1, At, B1); PG8_BAR; PG8_SCHED;
            PG8_LDA(At, 0, 1); PG8_STAGE(PG8_SB(0, 0), b2, voffB); PG8_STAGE(PG8_SB(0, 1), b2 + hstep, voffB); PG8_STAGE(PG8_SA(0, 0), a2, voffA);
            PG8_WAIT_V(8); PG8_WAIT_L(0); PG8_BAR; PG8_MMA(1, 0, At, B0); PG8_MMA(1, 1, At, B1); PG8_BAR; PG8_SCHED;
            PG8_LDB(B0, 1, 0); PG8_LDB(B1, 1, 1); PG8_SCHED; PG8_LDA(At, 1, 0); PG8_STAGE(PG8_SA(0, 1), a2 + hstep, voffA);
            PG8_WAIT_V(8); PG8_WAIT_L(0); PG8_BAR; PG8_MMA(0, 0, At, B0); PG8_MMA(0, 1, At, B1); PG8_BAR; PG8_SCHED;
            PG8_LDA(At, 1, 1); PG8_STAGE(PG8_SB(1, 0), b3, voffB); PG8_STAGE(PG8_SB(1, 1), b3 + hstep, voffB); PG8_STAGE(PG8_SA(1, 0), a3, voffA);
            PG8_WAIT_V(8); PG8_WAIT_L(0); PG8_BAR; PG8_MMA(1, 0, At, B0); PG8_MMA(1, 1, At, B1); PG8_BAR; PG8_SCHED;
            } else {
            PG8_LDB(B0, 0, 0); PG8_SCHED; PG8_LDA(At, 0, 0); PG8_STAGE(PG8_SA(1, 1), a1 + hstep, voffA);
            PG8_WAIT_L(8); PG8_BAR; PG8_WAIT_L(0); PG8_MMA(0, 0, At, B0); PG8_BAR; PG8_SCHED;
            PG8_LDB(B1, 0, 1); PG8_STAGE(PG8_SB(0, 0), b2, voffB);
            PG8_BAR; PG8_WAIT_L(0); PG8_MMA(0, 1, At, B1); PG8_BAR;
            PG8_LDA(At, 0, 1); PG8_STAGE(PG8_SA(0, 0), a2, voffA);
            PG8_BAR; PG8_WAIT_L(0); PG8_MMA(1, 0, At, B0); PG8_BAR; PG8_SCHED;
            PG8_STAGE(PG8_SB(0, 1), b2 + hstep, voffB);
            PG8_WAIT_V(6); PG8_BAR; PG8_MMA(1, 1, At, B1); PG8_BAR;
            PG8_LDB(B0, 1, 0); PG8_SCHED; PG8_LDA(At, 1, 0); PG8_STAGE(PG8_SA(0, 1), a2 + hstep, voffA);
            PG8_WAIT_L(8); PG8_BAR; PG8_WAIT_L(0); PG8_MMA(0, 0, At, B0); PG8_BAR; PG8_SCHED;
            PG8_LDB(B1, 1, 1); PG8_STAGE(PG8_SB(1, 0), b3, voffB);
            PG8_BAR; PG8_WAIT_L(0); PG8_MMA(0, 1, At, B1); PG8_BAR;
            PG8_LDA(At, 1, 1); PG8_STAGE(PG8_SA(1, 0), a3, voffA);
            PG8_BAR; PG8_WAIT_L(0); PG8_MMA(1, 0, At, B0); PG8_BAR; PG8_SCHED;
            PG8_STAGE(PG8_SB(1, 1), b3 + hstep, voffB);
            PG8_WAIT_V(6); PG8_BAR; PG8_MMA(1, 1, At, B1); PG8_BAR;
            }
        }
        if constexpr (ALIGN_EPI) { if (wr == 0) PG8_BAR; }
        if constexpr (!Epi::AFTER_DRAIN) { E(acc, cur, wr, wc, fr, fq); S.done(cur); }
        if (!has_next) break;
#pragma unroll
        for (int a = 0; a < 2; ++a)
#pragma unroll
            for (int b = 0; b < 2; ++b)
#pragma unroll
                for (int m = 0; m < 4; ++m)
#pragma unroll
                    for (int n = 0; n < 2; ++n) acc[a][b][m][n] = (f32x4){0.f, 0.f, 0.f, 0.f};
        cur = nxt; cA = nA; cB = nB; ++ui;
        if constexpr (ALIGN_EPI) { if (wr == 1) PG8_BAR; }
    }
    PG8_WAIT_V(0);
    if constexpr (!ALIGN_EPI) { if (wr == 0) PG8_BAR; }
    PG8_BAR;
    if constexpr (Epi::AFTER_DRAIN) { E.fused(acc, cur, wr, wc, fr, fq, lds, wid, lane); S.done(cur); }
#undef PG8_SA
#undef PG8_SB
#undef PG8_STAGE
#undef PG8_LDA
#undef PG8_LDB
#undef PG8_MMA
#undef PG8_WAIT_V
#undef PG8_WAIT_L
#undef PG8_BAR
#undef PG8_SCHED
}
}
constexpr int D = 1024, MCTX = 8192, MLAT = 32768, M = MCTX + MLAT;
constexpr int NAB = 3584, FF = 2816, NGU = 2 * FF, NC = 2048, NCOND = 9, MODW = 6 * D;
constexpr float EPS = 1e-6f;
constexpr int NWAVES = 8, NTHREADS = 512;
#ifndef ONE_LAUNCH
#define ONE_LAUNCH 1
#endif
constexpr int N_PHASES = 18;
#ifndef PH_MASK
#define PH_MASK 0x3ffff
#endif
#ifndef STAG_TICKS
#define STAG_TICKS 0
#endif
#ifndef ONE_LAUNCH
#define ONE_LAUNCH 1
#endif
constexpr size_t MiB = 1u << 20;
constexpr size_t WS_MOD = 0;
constexpr size_t WS_ROPE = 1 * MiB;
constexpr size_t WS_VSQ = 2 * MiB;
constexpr size_t WS_SHW = 512 * 1024;
constexpr size_t WS_RSQ = 4 * MiB + 512 * 1024;
constexpr size_t WS_BAR = 7 * MiB + 512 * 1024;
constexpr size_t WS_WAB = 8 * MiB;
constexpr size_t WS_WOAB = 15 * MiB;
constexpr size_t WS_WINC = 17 * MiB;
constexpr size_t WS_WOC = 21 * MiB;
constexpr size_t WS_WGU = 23 * MiB;
constexpr size_t WS_WDN = 45 * MiB;
constexpr size_t WS_HB = 56 * MiB;
constexpr size_t WS_YB = 136 * MiB;
constexpr size_t WS_P = 216 * MiB;
constexpr size_t WS_END = 496 * MiB;
constexpr int LDS_BYTES = 147456;
constexpr int MISC_OFF = LDS_BYTES - 64;
constexpr int TS = 136, TILE_B = 128 * TS * 2;
constexpr int VS = 264;

#define LAS __attribute__((address_space(3)))
typedef unsigned short bf16;
typedef unsigned v4u __attribute__((ext_vector_type(4)));
typedef unsigned v2u __attribute__((ext_vector_type(2)));
typedef float f32x4 __attribute__((ext_vector_type(4)));
typedef short bf16x8 __attribute__((ext_vector_type(8)));
typedef short s16x4 __attribute__((ext_vector_type(4)));
typedef LAS unsigned char* ldsp;

__device__ __forceinline__ float bflo(unsigned w) { return __uint_as_float(w << 16); }
__device__ __forceinline__ float bfhi(unsigned w) { return __uint_as_float(w & 0xffff0000u); }
__device__ __forceinline__ unsigned pk2(float lo, float hi) { return pg8::cvt_pk_bf16(lo, hi); }
__device__ __forceinline__ s16x4 vtr(const LAS unsigned char* p) { return __builtin_bit_cast(s16x4, __builtin_amdgcn_ds_read_tr16_b64_v4i16((LAS s16x4*)p)); }
__device__ __forceinline__ bf16x8 tr_frag(const LAS unsigned char* p, int off2) { const s16x4 a = vtr(p), b = vtr(p + off2); return __builtin_shufflevector(a, b, 0, 1, 2, 3, 4, 5, 6, 7); }
__device__ __forceinline__ f32x4 mfma16(bf16x8 a, bf16x8 b, f32x4 c) { return __builtin_amdgcn_mfma_f32_16x16x32_bf16(a, b, c, 0, 0, 0); }
__device__ __forceinline__ float wave_sum(float v) {
#pragma unroll
    for (int o = 1; o < 64; o <<= 1) v += __shfl_xor(v, o);
    return v;
}
__device__ __forceinline__ float log2_sigmoid(float x) { return -log1pf(expf(-x)) * 1.4426950408889634f; }

struct Args {
    const float* in[24]; float* out; unsigned char* ws; int ph_lo, ph_hi;
};

__device__ __forceinline__ void transpose_item(const float* W, int K, int N, bf16* WT, int k0, int n0, int dst_row0, float scale, LAS float* scr, int lane) {
    float wv[32];
#pragma unroll
    for (int i = 0; i < 32; ++i) wv[i] = W[(size_t)(k0 + 2 * i + (lane >> 5)) * N + n0 + (lane & 31)];
#pragma unroll
    for (int i = 0; i < 32; ++i) scr[(2 * i + (lane >> 5)) * 33 + (lane & 31)] = wv[i];
    asm volatile("s_waitcnt lgkmcnt(0)" ::: "memory");
    const int c = lane & 7;
#pragma unroll
    for (int j = 0; j < 4; ++j) { const int n = (lane >> 3) + 8 * j; const LAS float* s = scr + (8 * c) * 33 + n;
        v4u o; o.x = pk2(s[0 * 33] * scale, s[1 * 33] * scale); o.y = pk2(s[2 * 33] * scale, s[3 * 33] * scale); o.z = pk2(s[4 * 33] * scale, s[5 * 33] * scale); o.w = pk2(s[6 * 33] * scale, s[7 * 33] * scale);
        *(v4u*)(WT + pg8::tiled_off_b(dst_row0 + n, k0 + 8 * c, K)) = o; }
    asm volatile("s_waitcnt lgkmcnt(0)" ::: "memory");
}

constexpr int CONV_FIRST = 2304, CONV_EARLY = 5120, CONV_ALL = 12288;
__device__ __forceinline__ void convert_range(const Args& a, ldsp lds, int it_lo, int it_hi, int gw, int NGW, int lane, int wave) {
    unsigned char* ws = a.ws; LAS float* scr = (LAS float*)lds + wave * (64 * 33);
    for (int it = it_lo + gw; it < it_hi; it += NGW) {
        int r = it; const float* W; int K, N; bf16* WT; int mode = 0;
        if (r < 1792) { W = a.in[9]; K = 1024; N = NAB; WT = (bf16*)(ws + WS_WAB); mode = 3; }
        else if ((r -= 1792) < 512) { W = a.in[14]; K = 1024; N = 1024; WT = (bf16*)(ws + WS_WOAB); }
        else if ((r -= 512) < 1408) { W = a.in[20]; K = 1024; N = FF; WT = (bf16*)(ws + WS_WGU); mode = 1; }
        else if ((r -= 1408) < 1408) { W = a.in[21]; K = 1024; N = FF; WT = (bf16*)(ws + WS_WGU); mode = 2; }
        else if ((r -= 1408) < 1408) { W = a.in[22]; K = FF; N = 1024; WT = (bf16*)(ws + WS_WDN); }
        else if ((r -= 1408) < 1024) { W = a.in[15]; K = 1024; N = NC; WT = (bf16*)(ws + WS_WINC); }
        else if ((r -= 1024) < 512) { W = a.in[19]; K = 1024; N = 1024; WT = (bf16*)(ws + WS_WOC); }
        else if ((r -= 512) < 1408) { W = a.in[20] + (size_t)1024 * FF; K = 1024; N = FF; WT = (bf16*)(ws + WS_WGU) + (size_t)NGU * 1024; mode = 1; }
        else if ((r -= 1408) < 1408) { W = a.in[21] + (size_t)1024 * FF; K = 1024; N = FF; WT = (bf16*)(ws + WS_WGU) + (size_t)NGU * 1024; mode = 2; }
        else { r -= 1408; W = a.in[22] + (size_t)FF * 1024; K = FF; N = 1024; WT = (bf16*)(ws + WS_WDN) + (size_t)1024 * FF; }
        const int nblk = N / 32, kb = r / nblk, nb = r % nblk, k0 = 64 * kb, n0 = 32 * nb;
        int drow = n0; float scale = 1.0f;
        if (mode == 1) drow = (n0 >> 7) * 256 + (n0 & 127);
        else if (mode == 2) drow = (n0 >> 7) * 256 + 128 + (n0 & 127);
        else if (mode == 3 && n0 < 512) scale = 0.08838834764831845f;
        transpose_item(W, K, N, WT, k0, n0, drow, scale, scr, lane);
    }
}

__device__ __forceinline__ void p0_prologue(const Args& a, ldsp lds, int tid, int lane, int wave) {
    unsigned char* ws = a.ws;
    LAS float* L = (LAS float*)lds;
    const int bx = blockIdx.x, G = gridDim.x;
    for (int job = bx; job < 192; job += G) {
        const float* c = a.in[3]; const float* c_ctx = a.in[4]; const float* ada_w = a.in[5]; const float* ada_b = a.in[6];
        float* mod = (float*)(ws + WS_MOD);
        for (int e = tid; e < NCOND * 1024; e += NTHREADS) { const int b = e >> 10, k = e & 1023; const float cv = (b == 0) ? c_ctx[k] : c[(b - 1) * 1024 + k]; L[e] = cv / (1.0f + __expf(-cv)); }
        __syncthreads();
        const int l = job / 96, n0 = (job % 96) * 64;
        const float* W = ada_w + ((size_t)l * 1024 + 128 * wave) * MODW + n0 + lane;
        float acc[NCOND];
#pragma unroll
        for (int b = 0; b < NCOND; ++b) acc[b] = 0.f;
        for (int kk = 0; kk < 128; kk += 32) {
            float w[32];
#pragma unroll
            for (int u = 0; u < 32; ++u) w[u] = W[(size_t)(kk + u) * MODW];
#pragma unroll
            for (int u = 0; u < 32; ++u)
#pragma unroll
                for (int b = 0; b < NCOND; ++b) acc[b] += L[b * 1024 + 128 * wave + kk + u] * w[u];
        }
        LAS float* red = L + NCOND * 1024;
#pragma unroll
        for (int b = 0; b < NCOND; ++b) red[(wave * NCOND + b) * 64 + lane] = acc[b];
        __syncthreads();
        for (int e = tid; e < NCOND * 64; e += NTHREADS) { const int b = e >> 6, ln = e & 63; float s = ada_b[l * MODW + n0 + ln];
#pragma unroll
            for (int w = 0; w < 8; ++w) s += red[(w * NCOND + b) * 64 + ln];
            mod[(size_t)(l * NCOND + b) * MODW + n0 + ln] = s; }
        __syncthreads();
    }
    if (bx == G - 1) {
        float* tab = (float*)(ws + WS_ROPE);
        for (int e = tid; e < 2048; e += NTHREADS) { const int pos = e >> 5, f = e & 31; const float fr = exp2f(-(float)f * (13.287712379549449f / 32.0f)); const float ang = (float)pos * fr;
            float rev = ang * 0.15915494309189535f; rev -= floorf(rev); tab[e] = __builtin_amdgcn_cosf(rev); tab[2048 + e] = __builtin_amdgcn_sinf(rev); }
    }
    convert_range(a, lds, 0, G == 256 ? CONV_FIRST : CONV_ALL, bx * NWAVES + wave, G * NWAVES, lane, wave);
}

template <bool FIRST>
__device__ __forceinline__ void norm_pass(const Args& a, const float* gn, const float* modl, int off_sh, int off_sc, bf16* outp, int lane, int wave) {
    const int gw = blockIdx.x * NWAVES + wave, NGW = gridDim.x * NWAVES;
    for (int m0 = gw; m0 < M; m0 += 2 * NGW) {
        const int m1 = m0 + NGW; const bool two = m1 < M;
        f32x4 v[2][4]; float s[2] = {0.f, 0.f};
#pragma unroll
        for (int q = 0; q < 2; ++q) { const int m = (q == 0 || two) ? (q == 0 ? m0 : m1) : m0;
            const float* xrow = FIRST ? (m < MCTX ? a.in[0] + (size_t)m * D : a.in[1] + (size_t)(m - MCTX) * D) : a.out + (size_t)m * D;
            const f32x4* xr = (const f32x4*)xrow + lane;
#pragma unroll
            for (int j = 0; j < 4; ++j) v[q][j] = xr[64 * j]; }
#pragma unroll
        for (int q = 0; q < 2; ++q) {
#pragma unroll
            for (int j = 0; j < 4; ++j) s[q] += (v[q][j].x * v[q][j].x + v[q][j].y * v[q][j].y) + (v[q][j].z * v[q][j].z + v[q][j].w * v[q][j].w); }
#pragma unroll
        for (int q = 0; q < 2; ++q) { if (q == 1 && !two) break; const int m = q == 0 ? m0 : m1;
            const int cb = m < MCTX ? 0 : 1 + ((m - MCTX) >> 12);
            const float rstd = rsqrtf(wave_sum(s[q]) * (1.0f / D) + EPS);
            const float* mrow = modl + (size_t)cb * MODW;
#pragma unroll
            for (int j = 0; j < 4; ++j) { const int col = 4 * lane + 256 * j;
                const f32x4 g4 = *(const f32x4*)(gn + col), sc4 = *(const f32x4*)(mrow + off_sc + col), sh4 = *(const f32x4*)(mrow + off_sh + col);
                const f32x4 o = v[q][j] * rstd * g4 * (sc4 + 1.0f) + sh4;
                v2u w; w.x = pk2(o.x, o.y); w.y = pk2(o.z, o.w); *(v2u*)(outp + pg8::tiled_off(m, col, D)) = w; } }
    }
}
__device__ __forceinline__ void final_norm(const Args& a, const float* gn, int lane, int wave) {
    const int gw = blockIdx.x * NWAVES + wave, NGW = gridDim.x * NWAVES;
    for (int m = gw; m < M; m += NGW) {
        f32x4* xr = (f32x4*)(a.out + (size_t)m * D) + lane;
        f32x4 v[4]; float s = 0.f;
#pragma unroll
        for (int j = 0; j < 4; ++j) { v[j] = xr[64 * j]; s += (v[j].x * v[j].x + v[j].y * v[j].y) + (v[j].z * v[j].z + v[j].w * v[j].w); }
        const float rstd = rsqrtf(wave_sum(s) * (1.0f / D) + EPS);
#pragma unroll
        for (int j = 0; j < 4; ++j) { const f32x4 g4 = *(const f32x4*)(gn + 4 * lane + 256 * j); xr[64 * j] = v[j] * rstd * g4; }
    }
}

__device__ __forceinline__ void ld_tile(const bf16* src, int tid, v4u (&x)[2][2]) {
#pragma unroll
    for (int rep = 0; rep < 2; ++rep) { const int it = tid + rep * NTHREADS, tok = it >> 3, d0 = (it & 7) * 8;
        x[rep][0] = *(const v4u*)(src + (size_t)tok * NAB + d0); x[rep][1] = *(const v4u*)(src + (size_t)tok * NAB + 64 + d0); }
}
__device__ __forceinline__ void st_rope_tile(ldsp T, const v4u (&x)[2][2], bool rope, int tpos0, const float* tab, int tid) {
#pragma unroll
    for (int rep = 0; rep < 2; ++rep) { const int it = tid + rep * NTHREADS, tok = it >> 3, d0 = (it & 7) * 8;
        v4u x1 = x[rep][0], x2 = x[rep][1];
        if (rope) { const int tpos = tpos0 + tok, pos = d0 < 32 ? (tpos >> 6) : (tpos & 63), f0 = d0 & 31;
            const f32x4 c0 = *(const f32x4*)(tab + pos * 32 + f0), c1 = *(const f32x4*)(tab + pos * 32 + f0 + 4), s0 = *(const f32x4*)(tab + 2048 + pos * 32 + f0), s1 = *(const f32x4*)(tab + 2048 + pos * 32 + f0 + 4);
            const float cs[8] = {c0.x, c0.y, c0.z, c0.w, c1.x, c1.y, c1.z, c1.w}, sn[8] = {s0.x, s0.y, s0.z, s0.w, s1.x, s1.y, s1.z, s1.w};
            v4u o1, o2;
#pragma unroll
            for (int w = 0; w < 4; ++w) { const float a0 = bflo(x1[w]), a1 = bfhi(x1[w]), b0 = bflo(x2[w]), b1 = bfhi(x2[w]);
                o1[w] = pk2(a0 * cs[2 * w] - b0 * sn[2 * w], a1 * cs[2 * w + 1] - b1 * sn[2 * w + 1]);
                o2[w] = pk2(b0 * cs[2 * w] + a0 * sn[2 * w], b1 * cs[2 * w + 1] + a1 * sn[2 * w + 1]); }
            x1 = o1; x2 = o2; }
        *(LAS v4u*)(T + (tok * TS + d0) * 2) = x1; *(LAS v4u*)(T + (tok * TS + 64 + d0) * 2) = x2; }
}
__device__ __forceinline__ void ld_vtile(const bf16* src, int tid, v4u (&x)[4]) {
#pragma unroll
    for (int rep = 0; rep < 4; ++rep) { const int it = tid + rep * NTHREADS, tok = it >> 4, ch = it & 15; x[rep] = *(const v4u*)(src + (size_t)tok * NAB + ch * 8); }
}

__device__ __forceinline__ void r1_phase(const Args& a, ldsp lds, int tid0, int lane, int wave) {
    const bf16* P = (const bf16*)(a.ws + WS_P); bf16* UB = (bf16*)(a.ws + WS_YB); const float* tab = (const float*)(a.ws + WS_ROPE);
    const ldsp Kt = lds, Vf = lds + TILE_B, Vb = lds + 2 * TILE_B;
    const int r0 = lane & 15, kq0 = lane >> 4;
    v4u pk_[2][2], pv_[4];
    if ((int)blockIdx.x < 1280) { const int u = blockIdx.x; const bf16* Pg = P + (size_t)(u >> 2) * 128 * NAB; ld_tile(Pg + 512 + (u & 3) * 128, tid0, pk_); ld_vtile(Pg + 1024 + (u & 3) * 128, tid0, pv_); }
    for (int u = blockIdx.x; u < 1280; u += gridDim.x) {
        const int cidx = u >> 2, h = u & 3, row0 = cidx * 128; const bool lat = cidx >= 64; const int tpos0 = lat ? ((cidx - 64) & 31) * 128 : 0;
        const float l2f = log2_sigmoid(a.in[10][h]), l2b = log2_sigmoid(a.in[10][4 + h]);
        int tid = tid0, r = r0, kq = kq0; asm volatile("" : "+v"(tid), "+v"(r), "+v"(kq));
        __syncthreads();
        st_rope_tile(Kt, pk_, lat, tpos0, tab, tid);
#pragma unroll
        for (int rep = 0; rep < 4; ++rep) { const int it = tid + rep * NTHREADS, tok = it >> 4, ch = it & 15;
            const v4u x = pv_[rep];
            const float sf = __builtin_amdgcn_exp2f((float)(127 - tok) * l2f), sb = __builtin_amdgcn_exp2f((float)tok * l2b);
            v4u of, ob;
#pragma unroll
            for (int w = 0; w < 4; ++w) { const float lo = bflo(x[w]), hi = bfhi(x[w]); of[w] = pk2(lo * sf, hi * sf); ob[w] = pk2(lo * sb, hi * sb); }
            *(LAS v4u*)(Vf + (tok * TS + ch * 8) * 2) = of; *(LAS v4u*)(Vb + (tok * TS + ch * 8) * 2) = ob; }
        __syncthreads();
        { const int un = u + gridDim.x; if (un < 1280) { const bf16* Pn = P + (size_t)(un >> 2) * 128 * NAB; ld_tile(Pn + 512 + (un & 3) * 128, tid, pk_); ld_vtile(Pn + 1024 + (un & 3) * 128, tid, pv_); } }
        f32x4 acc[2][8];
#pragma unroll
        for (int d = 0; d < 2; ++d)
#pragma unroll
            for (int mt = 0; mt < 8; ++mt) acc[d][mt] = (f32x4){0.f, 0.f, 0.f, 0.f};
#pragma unroll
        for (int ks = 0; ks < 4; ++ks) { const int j0 = ks * 32 + kq * 8 + (r >> 2);
            const bf16x8 vfa = tr_frag(Vf + (j0 * TS + 16 * wave + 4 * (r & 3)) * 2, 8 * TS), vba = tr_frag(Vb + (j0 * TS + 16 * wave + 4 * (r & 3)) * 2, 8 * TS);
#pragma unroll
            for (int mt = 0; mt < 8; ++mt) { const bf16x8 ka = tr_frag(Kt + (j0 * TS + mt * 16 + 4 * (r & 3)) * 2, 8 * TS);
                acc[0][mt] = mfma16(ka, vfa, acc[0][mt]); acc[1][mt] = mfma16(ka, vba, acc[1][mt]); } }
#pragma unroll
        for (int d = 0; d < 2; ++d)
#pragma unroll
            for (int mt = 0; mt < 8; ++mt) { v2u w; w.x = pk2(acc[d][mt][0], acc[d][mt][1]); w.y = pk2(acc[d][mt][2], acc[d][mt][3]);
                *(v2u*)(UB + ((size_t)(u * 2 + d) * 128 + 16 * wave + r) * 128 + mt * 16 + 4 * kq) = w; }
    }
}

constexpr int SCAN_B = 8;
__device__ __forceinline__ void scan_item(const bf16* UB, bf16* SB, int cidx0, int n, int h, int dir, int e8, float dec, const float* S0, float* Sout) {
    const int dv = e8 >> 4, dk0 = (e8 & 15) * 8;
    float S[8];
#pragma unroll
    for (int i = 0; i < 8; ++i) S[i] = S0 ? S0[(size_t)(dk0 + i) * 128 + dv] : 0.f;
    for (int s0 = 0; s0 < n; s0 += SCAN_B) {
        v4u uu[SCAN_B]; size_t off[SCAN_B];
#pragma unroll
        for (int j = 0; j < SCAN_B; ++j) { const int st = s0 + j, c = dir == 0 ? st : n - 1 - st; off[j] = ((size_t)((cidx0 + c) * 4 + h) * 2 + dir) * 16384 + (size_t)e8 * 8;
            if (st < n) uu[j] = *(const v4u*)(UB + off[j]); else uu[j] = (v4u){0u, 0u, 0u, 0u}; }
#pragma unroll
        for (int j = 0; j < SCAN_B; ++j) { if (s0 + j < n) {
            v4u so; so.x = pk2(S[0], S[1]); so.y = pk2(S[2], S[3]); so.z = pk2(S[4], S[5]); so.w = pk2(S[6], S[7]);
            *(v4u*)(SB + off[j]) = so;
#pragma unroll
            for (int w = 0; w < 4; ++w) { S[2 * w] = dec * S[2 * w] + bflo(uu[j][w]); S[2 * w + 1] = dec * S[2 * w + 1] + bfhi(uu[j][w]); } } }
    }
    if (Sout) {
#pragma unroll
        for (int i = 0; i < 8; ++i) Sout[(size_t)(dk0 + i) * 128 + dv] = S[i]; }
}
__device__ __forceinline__ void r2_phase(const Args& a, int tid) {
    const bf16* UB = (const bf16*)(a.ws + WS_YB); bf16* SB = (bf16*)(a.ws + WS_HB);
    const int NT = gridDim.x * NTHREADS;
    for (int t = blockIdx.x * NTHREADS + tid; t < 131072; t += NT) {
        const int e8 = t & 2047, dir = (t >> 11) & 1, h = (t >> 12) & 3, s = t >> 14;
        const float dec = exp2f(128.0f * log2_sigmoid(a.in[10][dir * 4 + h]));
        scan_item(UB, SB, 64 + s * 32, 32, h, dir, e8, dec, a.in[2] + (size_t)((s * 2 + dir) * 4 + h) * 16384, nullptr);
    }
    for (int t = blockIdx.x * NTHREADS + tid; t < 524288; t += NT) {
        const int e8 = t & 2047, dir = (t >> 11) & 1, h = (t >> 12) & 3, s = t >> 14;
        const float dec = exp2f(128.0f * log2_sigmoid(a.in[10][dir * 4 + h]));
        scan_item(UB, SB, s * 2, 2, h, dir, e8, dec, nullptr, a.out + (size_t)M * D + (size_t)((s * 2 + dir) * 4 + h) * 16384);
    }
}

__device__ __forceinline__ void r3_phase(const Args& a, ldsp lds, int tid0, int lane, int wave) {
    const bf16* P = (const bf16*)(a.ws + WS_P); const bf16* SB = (const bf16*)(a.ws + WS_HB); bf16* YB = (bf16*)(a.ws + WS_YB); const float* tab = (const float*)(a.ws + WS_ROPE);
    const ldsp Qt = lds, Kt = lds + TILE_B, Vt = lds + 2 * TILE_B, Pt = lds + 3 * TILE_B;
    const int r0 = lane & 15, kq0 = lane >> 4;
#ifndef NO_RET
    v4u pq_[2][2], pk_[2][2], pv_[4];
    v4u pg_[4];
    if ((int)blockIdx.x < 1280) { const int u = blockIdx.x, ln = tid0 & 63; const bf16* gp = P + (size_t)((u >> 2) * 128 + 16 * wave + (ln >> 2)) * NAB + 1536 + (u & 3) * 128 + (ln & 3) * 32;
#pragma unroll
        for (int k = 0; k < 4; ++k) pg_[k] = *(const v4u*)(gp + k * 8); }
    if ((int)blockIdx.x < 1280) { const int u = blockIdx.x; const bf16* Pg0 = P + (size_t)(u >> 2) * 128 * NAB; ld_tile(Pg0 + (u & 3) * 128, tid0, pq_); ld_tile(Pg0 + 512 + (u & 3) * 128, tid0, pk_); ld_vtile(Pg0 + 1024 + (u & 3) * 128, tid0, pv_); }
    for (int u = blockIdx.x; u < 1280; u += gridDim.x) {
        const int cidx = u >> 2, h = u & 3, row0 = cidx * 128; const bool lat = cidx >= 64; const int tpos0 = lat ? ((cidx - 64) & 31) * 128 : 0;
        const float l2f = log2_sigmoid(a.in[10][h]), l2b = log2_sigmoid(a.in[10][4 + h]);
        const bf16* Pg = P + (size_t)row0 * NAB;
        int tid = tid0, r = r0, kq = kq0; asm volatile("" : "+v"(tid), "+v"(r), "+v"(kq));
        __syncthreads();
        st_rope_tile(Qt, pq_, lat, tpos0, tab, tid);
        st_rope_tile(Kt, pk_, lat, tpos0, tab, tid);
#pragma unroll
        for (int rep = 0; rep < 4; ++rep) { const int it = tid + rep * NTHREADS, tok = it >> 4, ch = it & 15; *(LAS v4u*)(Vt + (tok * TS + ch * 8) * 2) = pv_[rep]; }
        __syncthreads();
        { const int un = u + gridDim.x; if (un < 1280) { const bf16* Pn = P + (size_t)(un >> 2) * 128 * NAB; ld_tile(Pn + (un & 3) * 128, tid, pq_); ld_tile(Pn + 512 + (un & 3) * 128, tid, pk_); ld_vtile(Pn + 1024 + (un & 3) * 128, tid, pv_); } }
        const int il = 16 * wave + r;
        int ilq = il - 4 * kq; asm volatile("" : "+v"(ilq));
        bf16x8 qf[4];
#pragma unroll
        for (int ks = 0; ks < 4; ++ks) qf[ks] = *(const LAS bf16x8*)(Qt + (il * TS + ks * 32 + kq * 8) * 2);
#pragma unroll
        for (int nt = 0; nt < 8; ++nt) { f32x4 c = (f32x4){0.f, 0.f, 0.f, 0.f};
#pragma unroll
            for (int ks = 0; ks < 4; ++ks) { const bf16x8 kf = *(const LAS bf16x8*)(Kt + ((nt * 16 + r) * TS + ks * 32 + kq * 8) * 2); c = mfma16(kf, qf[ks], c); }
            float p[4];
#pragma unroll
            for (int e = 0; e < 4; ++e) { const float fd = (float)(ilq - (nt * 16 + e));
                const float dm = (fd == 0.0f) ? 2.0f : __builtin_amdgcn_exp2f(fmaxf(fd, 0.0f) * l2f + fmaxf(-fd, 0.0f) * l2b); p[e] = c[e] * dm; }
            v2u w; w.x = pk2(p[0], p[1]); w.y = pk2(p[2], p[3]);
            *(LAS v2u*)(Pt + (il * TS + nt * 16 + 4 * kq) * 2) = w; asm volatile("" ::: "memory"); }
        asm volatile("s_waitcnt lgkmcnt(0)" ::: "memory");
        __syncthreads();
        const bool zf = !lat && (cidx & 1) == 0, zb = !lat && (cidx & 1) == 1;
        v4u sreg[4];
        if (!zf) { const bf16* Sg = SB + (size_t)(u * 2) * 16384;
#pragma unroll
          for (int rep = 0; rep < 4; ++rep) { const int it = tid + rep * NTHREADS; sreg[rep] = *(const v4u*)(Sg + (it >> 4) * 128 + (it & 15) * 8); } }
        f32x4 oi[8];
#pragma unroll
        for (int nt = 0; nt < 8; ++nt) oi[nt] = (f32x4){0.f, 0.f, 0.f, 0.f};
#pragma unroll
        for (int ks = 0; ks < 4; ++ks) { const bf16x8 pf = *(const LAS bf16x8*)(Pt + (il * TS + ks * 32 + kq * 8) * 2); const int j0 = ks * 32 + kq * 8 + (r >> 2);
#pragma unroll
            for (int nt = 0; nt < 8; ++nt) { const bf16x8 vf = tr_frag(Vt + (j0 * TS + nt * 16 + 4 * (r & 3)) * 2, 8 * TS); oi[nt] = mfma16(pf, vf, oi[nt]); }
            asm volatile("" ::: "memory"); }
        if (!zf) {
#pragma unroll
            for (int rep = 0; rep < 4; ++rep) { const int it = tid + rep * NTHREADS; *(LAS v4u*)(Kt + ((it >> 4) * TS + (it & 15) * 8) * 2) = sreg[rep]; } }
        __syncthreads();
        if (!zb) { const bf16* Sg = SB + (size_t)(u * 2 + 1) * 16384;
#pragma unroll
          for (int rep = 0; rep < 4; ++rep) { const int it = tid + rep * NTHREADS; sreg[rep] = *(const v4u*)(Sg + (it >> 4) * 128 + (it & 15) * 8); } }
        int iq = 16 * wave + 4 * kq; asm volatile("" : "+v"(iq));
#pragma unroll
        for (int dir = 0; dir < 2; ++dir) {
            const ldsp St = dir == 0 ? Kt : Vt;
            if (dir == 1) {
                if (!zb) {
#pragma unroll
                    for (int rep = 0; rep < 4; ++rep) { const int it = tid + rep * NTHREADS; *(LAS v4u*)(Vt + ((it >> 4) * TS + (it & 15) * 8) * 2) = sreg[rep]; } }
                __syncthreads();
            }
            if (dir == 0 ? zf : zb) continue;
            float cr[4];
#pragma unroll
            for (int e = 0; e < 4; ++e) cr[e] = dir == 0 ? __builtin_amdgcn_exp2f((float)(iq + e + 1) * l2f) : __builtin_amdgcn_exp2f((float)(128 - iq - e) * l2b);
#pragma unroll
            for (int nt = 0; nt < 8; ++nt) {
                f32x4 t = (f32x4){0.f, 0.f, 0.f, 0.f};
#pragma unroll
                for (int ks = 0; ks < 4; ++ks) { const bf16x8 sf = *(const LAS bf16x8*)(St + ((nt * 16 + r) * TS + ks * 32 + kq * 8) * 2); t = mfma16(qf[ks], sf, t); }
#pragma unroll
                for (int e = 0; e < 4; ++e) oi[nt][e] += cr[e] * t[e];
                asm volatile("" ::: "memory");
            }
        }
        float ss[4];
#pragma unroll
        for (int e = 0; e < 4; ++e) { float s = 0.f;
#pragma unroll
            for (int nt = 0; nt < 8; ++nt) s += oi[nt][e] * oi[nt][e];
            s += __shfl_xor(s, 1); s += __shfl_xor(s, 2); s += __shfl_xor(s, 4); s += __shfl_xor(s, 8);
            ss[e] = rsqrtf(s * (1.0f / 128.0f) + EPS); }
#pragma unroll
        for (int nt = 0; nt < 8; ++nt)
#pragma unroll
            for (int e = 0; e < 4; ++e) *(LAS bf16*)(Pt + ((16 * wave + 4 * kq + e) * TS + nt * 16 + r) * 2) = (bf16)(pk2(oi[nt][e] * ss[e], 0.f) & 0xffffu);
        asm volatile("s_waitcnt lgkmcnt(0)" ::: "memory");
        { const int ln = kq * 16 + r, rw = ln >> 2, c4 = ln & 3, lrow = 16 * wave + rw; const float* rg = a.in[11] + h * 128 + c4 * 32;
#pragma unroll
            for (int k = 0; k < 4; ++k) { const v4u o8 = *(const LAS v4u*)(Pt + (lrow * TS + c4 * 32 + k * 8) * 2); const v4u g8 = pg_[k];
                const f32x4 r0 = *(const f32x4*)(rg + k * 8), r1 = *(const f32x4*)(rg + k * 8 + 4); const float rgv[8] = {r0.x, r0.y, r0.z, r0.w, r1.x, r1.y, r1.z, r1.w};
                v4u y;
#pragma unroll
                for (int w = 0; w < 4; ++w) { const float g0 = bflo(g8[w]), g1 = bfhi(g8[w]);
                    y[w] = pk2(g0 * pg8::fast_sigmoid(g0) * bflo(o8[w]) * rgv[2 * w], g1 * pg8::fast_sigmoid(g1) * bfhi(o8[w]) * rgv[2 * w + 1]); }
                *(v4u*)(YB + pg8::tiled_off(row0 + lrow, h * 128 + c4 * 32 + k * 8, D)) = y; }
            const int un = u + gridDim.x; if (un < 1280) { const bf16* gp = P + (size_t)((un >> 2) * 128 + lrow) * NAB + 1536 + (un & 3) * 128 + c4 * 32;
#pragma unroll
                for (int k = 0; k < 4; ++k) pg_[k] = *(const v4u*)(gp + k * 8); } }
    }
#endif
#ifndef NO_CONV
    {
        const float* cw = a.in[12]; const float* cbv = a.in[13];
        const int NT = gridDim.x * NTHREADS, gt = blockIdx.x * NTHREADS + tid0, c0 = (gt & 63) * 8;
        float w0[8], w1[8], w2[8], bb[8];
#pragma unroll
        for (int q = 0; q < 2; ++q) { const f32x4 t0 = *(const f32x4*)(cw + c0 + 4 * q), t1 = *(const f32x4*)(cw + 512 + c0 + 4 * q), t2 = *(const f32x4*)(cw + 1024 + c0 + 4 * q), t3 = *(const f32x4*)(cbv + c0 + 4 * q);
#pragma unroll
            for (int j = 0; j < 4; ++j) { w0[4 * q + j] = t0[j]; w1[4 * q + j] = t1[j]; w2[4 * q + j] = t2[j]; bb[4 * q + j] = t3[j]; } }
        for (int it = gt; it < (M / 4) * 64; it += NT) {
            const int m0 = (it >> 6) * 4;
            const int slen = m0 < MCTX ? 256 : 4096, pos0 = m0 < MCTX ? (m0 & 255) : ((m0 - MCTX) & 4095);
            const bf16* Pm = P + (size_t)m0 * NAB;
            v4u cg[6], xc[6], bg[4];
#pragma unroll
            for (int q = 0; q < 6; ++q) { const bool ok = (q == 0) ? (pos0 > 0) : ((q == 5) ? (pos0 + 4 < slen) : true);
                if (ok) { cg[q] = *(const v4u*)(Pm + (ptrdiff_t)(q - 1) * NAB + 2560 + c0); xc[q] = *(const v4u*)(Pm + (ptrdiff_t)(q - 1) * NAB + 3072 + c0); } else { cg[q] = (v4u){0u, 0u, 0u, 0u}; xc[q] = cg[q]; } }
#pragma unroll
            for (int q = 0; q < 4; ++q) bg[q] = *(const v4u*)(Pm + (size_t)q * NAB + 2048 + c0);
            float z[6][8];
#pragma unroll
            for (int q = 0; q < 6; ++q)
#pragma unroll
                for (int w = 0; w < 4; ++w) { z[q][2 * w] = bflo(cg[q][w]) * bflo(xc[q][w]); z[q][2 * w + 1] = bfhi(cg[q][w]) * bfhi(xc[q][w]); }
#pragma unroll
            for (int q = 0; q < 4; ++q) { v4u y;
#pragma unroll
                for (int w = 0; w < 4; ++w) {
                    const float y0 = bflo(bg[q][w]) * (w0[2 * w] * z[q][2 * w] + w1[2 * w] * z[q + 1][2 * w] + w2[2 * w] * z[q + 2][2 * w] + bb[2 * w]);
                    const float y1 = bfhi(bg[q][w]) * (w0[2 * w + 1] * z[q][2 * w + 1] + w1[2 * w + 1] * z[q + 1][2 * w + 1] + w2[2 * w + 1] * z[q + 2][2 * w + 1] + bb[2 * w + 1]);
                    y[w] = pk2(y0, y1); }
                *(v4u*)(YB + pg8::tiled_off(m0 + q, 512 + c0, D)) = y; }
        }
    }
#endif
}

__device__ __forceinline__ void spatial_phase(const Args& a, ldsp lds, int tid0, int lane, int wave) {
    const bf16* Z = (const bf16*)(a.ws + WS_P); bf16* YB = (bf16*)(a.ws + WS_YB); const float* vsq = (const float*)(a.ws + WS_VSQ);
    const float* w_s = a.in[17]; const float* b_s = a.in[18]; const float* vg = a.in[16];
    const ldsp At = lds, Vt = lds + TILE_B; LAS float* rs = (LAS float*)(lds + TILE_B + 128 * VS * 2);
    const int r0 = lane & 15, kq0 = lane >> 4;
    for (int u = blockIdx.x; u < 1280; u += gridDim.x) {
        const int cidx = u >> 2, g = u & 3, row0 = cidx * 128;
        int tid = tid0, r = r0, kq = kq0; asm volatile("" : "+v"(tid), "+v"(r), "+v"(kq));
        __syncthreads();
        if (tid < 128) { const f32x4* vp = (const f32x4*)(vsq + (size_t)(row0 + tid) * 16); const f32x4 s0 = vp[0], s1 = vp[1], s2 = vp[2], s3 = vp[3];
            const float s = ((s0.x + s0.y) + (s0.z + s0.w)) + ((s1.x + s1.y) + (s1.z + s1.w)) + ((s2.x + s2.y) + (s2.z + s2.w)) + ((s3.x + s3.y) + (s3.z + s3.w));
            rs[tid] = rsqrtf(s * (1.0f / 1024.0f) + EPS); }
#pragma unroll
        for (int rep = 0; rep < 8; ++rep) { const int it = tid + rep * NTHREADS, q = it >> 5, c = it & 31;
            *(LAS v4u*)(Vt + (q * VS + c * 8) * 2) = *(const v4u*)(Z + (size_t)(row0 + q) * NC + 1024 + g * 256 + c * 8); }
        __syncthreads();
#pragma unroll
        for (int rep = 0; rep < 4; ++rep) { const int it = tid + rep * NTHREADS, p = it >> 4, c = it & 15;
            const f32x4 w0 = *(const f32x4*)(w_s + (size_t)(g * 128 + p) * 128 + c * 8), w1 = *(const f32x4*)(w_s + (size_t)(g * 128 + p) * 128 + c * 8 + 4);
            const LAS float* rq = rs + c * 8;
            v4u o; o.x = pk2(w0.x * rq[0], w0.y * rq[1]); o.y = pk2(w0.z * rq[2], w0.w * rq[3]); o.z = pk2(w1.x * rq[4], w1.y * rq[5]); o.w = pk2(w1.z * rq[6], w1.w * rq[7]);
            *(LAS v4u*)(At + (p * TS + c * 8) * 2) = o; }
        __syncthreads();
        f32x4 acc[2][8];
#pragma unroll
        for (int n2 = 0; n2 < 2; ++n2)
#pragma unroll
            for (int mt = 0; mt < 8; ++mt) acc[n2][mt] = (f32x4){0.f, 0.f, 0.f, 0.f};
#pragma unroll
        for (int ks = 0; ks < 4; ++ks) { const int q0 = ks * 32 + kq * 8 + (r >> 2);
            const bf16x8 va0 = tr_frag(Vt + (q0 * VS + 32 * wave + 4 * (r & 3)) * 2, 8 * VS), va1 = tr_frag(Vt + (q0 * VS + 32 * wave + 16 + 4 * (r & 3)) * 2, 8 * VS);
#pragma unroll
            for (int mt = 0; mt < 8; ++mt) { const bf16x8 wf = *(const LAS bf16x8*)(At + ((mt * 16 + r) * TS + ks * 32 + kq * 8) * 2);
                acc[0][mt] = mfma16(va0, wf, acc[0][mt]); acc[1][mt] = mfma16(va1, wf, acc[1][mt]); } }
#pragma unroll
        for (int n2 = 0; n2 < 2; ++n2) { const int gch = g * 256 + 32 * wave + 16 * n2 + 4 * kq; const f32x4 vg4 = *(const f32x4*)(vg + gch);
#pragma unroll
            for (int mt = 0; mt < 8; ++mt) { const int p = mt * 16 + r; const float bsp = b_s[g * 128 + p];
                const v2u uu = *(const v2u*)(Z + (size_t)(row0 + p) * NC + gch);
                const float s0 = acc[n2][mt][0] * vg4.x + bsp, s1 = acc[n2][mt][1] * vg4.y + bsp, s2 = acc[n2][mt][2] * vg4.z + bsp, s3 = acc[n2][mt][3] * vg4.w + bsp;
                v2u y; y.x = pk2(bflo(uu.x) * s0, bfhi(uu.x) * s1); y.y = pk2(bflo(uu.y) * s2, bfhi(uu.y) * s3);
                *(v2u*)(YB + pg8::tiled_off(row0 + p, gch, D)) = y; } }
    }
}

__device__ __forceinline__ void shw_phase(const Args& a, int lane, int rw_lo, int rw_hi, int gw, int NGW) {
    unsigned char* ws = a.ws; const float* mod0 = (const float*)(ws + WS_MOD); const float* mod1 = mod0 + NCOND * MODW; float* shw = (float*)(ws + WS_SHW);
    for (int rw = rw_lo + gw; rw < rw_hi; rw += NGW) {
        const bf16* wrow; const float* sh; float* dst; int nb, n;
        if (rw < NGU) { n = rw; wrow = (const bf16*)(ws + WS_WGU); sh = mod0 + 3072; dst = shw; nb = NGU; }
        else if (rw < NGU + NC) { n = rw - NGU; wrow = (const bf16*)(ws + WS_WINC); sh = mod1; dst = shw + NCOND * NGU; nb = NC; }
        else { n = rw - NGU - NC; wrow = (const bf16*)(ws + WS_WGU) + (size_t)NGU * 1024; sh = mod1 + 3072; dst = shw + NCOND * (NGU + NC); nb = NGU; }
        const v4u w0 = *(const v4u*)(wrow + pg8::tiled_off_b(n, lane * 16, 1024)), w1 = *(const v4u*)(wrow + pg8::tiled_off_b(n, lane * 16 + 8, 1024));
        float wf[16];
#pragma unroll
        for (int q = 0; q < 4; ++q) { wf[2 * q] = bflo(w0[q]); wf[2 * q + 1] = bfhi(w0[q]); wf[8 + 2 * q] = bflo(w1[q]); wf[8 + 2 * q + 1] = bfhi(w1[q]); }
#pragma unroll
        for (int cb = 0; cb < NCOND; ++cb) { const f32x4* sp = (const f32x4*)(sh + (size_t)cb * MODW + lane * 16); float s = 0.f;
#pragma unroll
            for (int q = 0; q < 4; ++q) { const f32x4 t = sp[q]; s += (t.x * wf[4 * q] + t.y * wf[4 * q + 1]) + (t.z * wf[4 * q + 2] + t.w * wf[4 * q + 3]); }
            s = wave_sum(s); if (lane == 0) dst[(size_t)cb * nb + n] = s; }
    }
}

__device__ __forceinline__ void fn_row(const v4u x0, const v4u x1, float* yrow, const float* gn, int lane) {
    float v[16];
#pragma unroll
    for (int q = 0; q < 4; ++q) { v[2 * q] = bflo(x0[q]); v[2 * q + 1] = bfhi(x0[q]); v[8 + 2 * q] = bflo(x1[q]); v[8 + 2 * q + 1] = bfhi(x1[q]); }
    float s = 0.f;
#pragma unroll
    for (int q = 0; q < 16; ++q) s += v[q] * v[q];
    const float rstd = rsqrtf(wave_sum(s) * (1.0f / D) + EPS);
#pragma unroll
    for (int c = 0; c < 2; ++c) { const int col = 8 * lane + 512 * c; const f32x4 g0 = *(const f32x4*)(gn + col), g1 = *(const f32x4*)(gn + col + 4);
        *(f32x4*)(yrow + col) = (f32x4){v[8 * c] * rstd * g0.x, v[8 * c + 1] * rstd * g0.y, v[8 * c + 2] * rstd * g0.z, v[8 * c + 3] * rstd * g0.w};
        *(f32x4*)(yrow + col + 4) = (f32x4){v[8 * c + 4] * rstd * g1.x, v[8 * c + 5] * rstd * g1.y, v[8 * c + 6] * rstd * g1.z, v[8 * c + 7] * rstd * g1.w}; }
}
__device__ __forceinline__ void final_norm_direct(const bf16* src, int src_row0, float* y, const float* gn, int m_lo, int m_hi, int lane, int wave) {
    const int gw = blockIdx.x * NWAVES + wave, NGW = gridDim.x * NWAVES;
    for (int m = m_lo + gw; m < m_hi; m += 2 * NGW) { const int mb = m + NGW; const bool two = mb < m_hi;
        const bf16* xr = src + (size_t)(m - src_row0) * D + 8 * lane; const bf16* xs = src + (size_t)((two ? mb : m) - src_row0) * D + 8 * lane;
        const v4u x0 = *(const v4u*)xr, x1 = *(const v4u*)(xr + 512), z0 = *(const v4u*)xs, z1 = *(const v4u*)(xs + 512);
        fn_row(x0, x1, y + (size_t)m * D, gn, lane); if (two) fn_row(z0, z1, y + (size_t)mb * D, gn, lane); }
}
constexpr int FN_SPLIT = M / 2;
#define XB_TMO      128
#define XB_XCNT(j)  (256  + 64 * (j))
#define XB_XSUB(j)  (1280 + 64 * (j))
#define XB_XGEN(j)  (2304 + 64 * (j))
#define XB_TOP      3328
#define XB_TOPGEN   3392
#define XCD_BAR_WORDS 3456
#define XB_SPIN_CAP (1u << 18)

__device__ __forceinline__ unsigned xb_ld(unsigned* p)              { return __hip_atomic_load(p, __ATOMIC_RELAXED, __HIP_MEMORY_SCOPE_AGENT); }
__device__ __forceinline__ unsigned xb_add(unsigned* p, unsigned v) { return __hip_atomic_fetch_add(p, v, __ATOMIC_RELAXED, __HIP_MEMORY_SCOPE_AGENT); }
__device__ __forceinline__ unsigned xb_xcc_id() { return (unsigned)__builtin_amdgcn_s_getreg((3 << 11) | 20) & 0xFu; }
#define XB_SPIN(cond, bar) do { unsigned _sp = 0; while (cond) { __builtin_amdgcn_s_sleep(1); \
    if ((++_sp & 255u) == 0u) { if (xb_ld(&(bar)[XB_TMO])) break; if (_sp > XB_SPIN_CAP) { atomicAdd(&(bar)[XB_TMO], 1u); break; } } } } while (0)

struct XcdBarrier {
    unsigned* bar; unsigned x;
    volatile LAS unsigned* st;
};

__device__ __forceinline__ XcdBarrier xcd_barrier_post(unsigned* bar, volatile LAS unsigned* st) {
    XcdBarrier b; b.bar = bar; b.x = xb_xcc_id(); b.st = st;
    if (threadIdx.x == 0) (void)xb_add(&bar[XB_XCNT(b.x)], 1u);
    return b;
}
__device__ __forceinline__ void xcd_barrier_complete(unsigned* bar, unsigned x, unsigned& nloc, unsigned& nx) {
    const unsigned G = gridDim.x * gridDim.y * gridDim.z;
    unsigned sum, cnt, mine, sp = 0u;
    for (;;) {
        sum = 0u; cnt = 0u; mine = 0u;
#pragma unroll
        for (unsigned j = 0; j < 16; ++j) { const unsigned c = xb_ld(&bar[XB_XCNT(j)]); sum += c; cnt += (c > 0u) ? 1u : 0u; mine = (j == x) ? c : mine; }
        if (sum == G) break;
        __builtin_amdgcn_s_sleep(1);
        if ((++sp & 255u) == 0u) { if (xb_ld(&bar[XB_TMO])) break; if (sp > XB_SPIN_CAP) { atomicAdd(&bar[XB_TMO], 1u); break; } }
    }
    nloc = mine > 0u ? mine : 1u; nx = cnt > 0u ? cnt : 1u;
}

__device__ __forceinline__ void xcd_barrier(const XcdBarrier& b) {
    asm volatile("s_waitcnt vmcnt(0)" ::: "memory");
    __syncthreads();
    if (threadIdx.x == 0) {
        unsigned* bar = b.bar;
        __builtin_amdgcn_s_waitcnt(0);
        unsigned nloc = b.st[0], nx = b.st[1];
        if (nloc == 0u) { xcd_barrier_complete(bar, b.x, nloc, nx); b.st[0] = nloc; b.st[1] = nx; }
        const unsigned old = xb_add(&bar[XB_XSUB(b.x)], 1u);
        const unsigned gen = old / nloc;
        if (old + 1u == (gen + 1u) * nloc) {
            __builtin_amdgcn_fence(__ATOMIC_RELEASE, "agent");
            asm volatile("s_waitcnt vmcnt(0)" ::: "memory");
            const unsigned og = xb_add(&bar[XB_TOP], 1u);
            const unsigned tg = og / nx;
            if (og + 1u == (tg + 1u) * nx) xb_add(&bar[XB_TOPGEN], 1u);
            else XB_SPIN(xb_ld(&bar[XB_TOPGEN]) == tg, bar);
            __builtin_amdgcn_fence(__ATOMIC_ACQUIRE, "agent");
            xb_add(&bar[XB_XGEN(b.x)], 1u);
            asm volatile("s_waitcnt vmcnt(0)" ::: "memory");
        } else {
            XB_SPIN(xb_ld(&bar[XB_XGEN(b.x)]) == gen, bar);
            __builtin_amdgcn_fence(__ATOMIC_ACQUIRE, "agent");
            asm volatile("s_waitcnt vmcnt(0)" ::: "memory");
        }
    }
    __syncthreads();
}

__global__ void __launch_bounds__(NTHREADS, 2) mega_fwd(Args a) {
    extern __shared__ __attribute__((aligned(16))) unsigned char lds_raw[];
    const ldsp lds = (ldsp)lds_raw;
    const int tid = threadIdx.x, lane = tid & 63, wave = __builtin_amdgcn_readfirstlane(tid >> 6);
    unsigned char* ws = a.ws;
    float* mod0 = (float*)(ws + WS_MOD); float* mod1 = mod0 + NCOND * MODW;
    bf16* HB = (bf16*)(ws + WS_HB); bf16* YB = (bf16*)(ws + WS_YB); bf16* PB = (bf16*)(ws + WS_P);
    const int G = gridDim.x, bx = blockIdx.x;
#if ONE_LAUNCH
    volatile LAS unsigned* misc = (volatile LAS unsigned*)(lds + MISC_OFF);
    if (tid < 16) misc[tid] = 0u;
    __syncthreads();
    const XcdBarrier xbar = xcd_barrier_post((unsigned*)(ws + WS_BAR), misc);
#endif
#define IN(k) (((PH_MASK >> (k)) & 1) && a.ph_lo <= (k) && (k) < a.ph_hi)
#define INN(k) (a.ph_lo <= (k) && (k) < a.ph_hi)
#if ONE_LAUNCH
#define SEAM(k) do { if (INN(k) && INN((k) + 1)) xcd_barrier(xbar); } while (0)
#else
#define SEAM(k) do { } while (0)
#endif
#define STAGGER(ticks) do { if (ONE_LAUNCH && (ticks) > 0) { const unsigned long long t0_ = __builtin_amdgcn_s_memrealtime(); const unsigned long long dl_ = (unsigned long long)(((bx >> 3) & 31) * (ticks)) >> 5; \
        while (__builtin_amdgcn_s_memrealtime() - t0_ < dl_) __builtin_amdgcn_s_sleep(16); } } while (0)
#define GEMM(EpiT, Aop, Bop, Nn, Kk, Eobj) do { pg8::Gemm g_{(const pg8::bf16_t*)(Aop), (const pg8::bf16_t*)(Bop), M, (Nn), (Kk)}; pg8::StaticOrder S_; S_.init(M, (Nn), G, bx); \
        pg8::gemm_phase<EpiT, pg8::StaticOrder, true, true>(lds, g_, S_, (Eobj)); } while (0)

#if ONE_LAUNCH
    if (a.ph_lo < 0) cg::this_grid().sync();
#endif
    if (IN(0)) p0_prologue(a, lds, tid, lane, wave);
    SEAM(0);
    if (IN(1)) { norm_pass<true>(a, a.in[7], mod0, 0, 1024, HB, lane, wave); if (G != 256) shw_phase(a, lane, 0, 2 * NGU + NC, bx * NWAVES + wave, G * NWAVES); }
    SEAM(1);
    if (IN(2)) { pg8::EpiStoreBf16 E{PB, NAB}; GEMM(pg8::EpiStoreBf16, HB, ws + WS_WAB, NAB, 1024, E);
        if (G == 256 && bx >= 192) convert_range(a, lds, CONV_FIRST, CONV_EARLY, (bx - 192) * NWAVES + wave, 64 * NWAVES, lane, wave); }
    SEAM(2);
    if (IN(3)) r1_phase(a, lds, tid, lane, wave);
    SEAM(3);
    if (IN(4)) r2_phase(a, tid);
    SEAM(4);
    if (IN(5)) r3_phase(a, lds, tid, lane, wave);
    SEAM(5);
    float* rsq = (float*)(ws + WS_RSQ); const float* shw = (const float*)(ws + WS_SHW);
    bf16* XB0 = (bf16*)a.out; bf16* XB1 = XB0 + (size_t)M * D;
    typedef pg8::EpiResidB<true, true> EpiR0; typedef pg8::EpiResidB<false, true> EpiR1; typedef pg8::EpiResidB<false, false> EpiR2;
    if (IN(6)) { EpiR0 E{a.in[0], a.in[1], nullptr, XB0, mod0 + 2048, HB, a.in[8], mod0 + 4096, rsq}; GEMM(EpiR0, YB, ws + WS_WOAB, 1024, 1024, E);
        if (G == 256 && bx >= 128) { shw_phase(a, lane, 0, NGU, (bx - 128) * NWAVES + wave, 128 * NWAVES); convert_range(a, lds, CONV_EARLY, CONV_ALL, (bx - 128) * NWAVES + wave, 128 * NWAVES, lane, wave); } }
    SEAM(6);
    if (IN(8)) { pg8::EpiSwiglu E{PB, FF, rsq, shw, NGU}; GEMM(pg8::EpiSwiglu, HB, ws + WS_WGU, NGU, 1024, E); }
    SEAM(8);
    if (IN(9)) { EpiR1 E{nullptr, nullptr, XB0, XB1, mod0 + 5120, HB, a.in[7] + D, mod1 + 1024, rsq}; GEMM(EpiR1, PB, ws + WS_WDN, 1024, FF, E);
        if (G == 256 && bx >= 128) shw_phase(a, lane, NGU, 2 * NGU + NC, (bx - 128) * NWAVES + wave, 128 * NWAVES); }
    SEAM(9);
    if (IN(11)) { pg8::EpiGeluSq E{PB, NC, (float*)(ws + WS_VSQ), 4, rsq, shw + NCOND * NGU, NC}; GEMM(pg8::EpiGeluSq, HB, ws + WS_WINC, NC, 1024, E); }
    SEAM(11);
    if (IN(12)) spatial_phase(a, lds, tid, lane, wave);
    SEAM(12);
    if (IN(13)) { EpiR1 E{nullptr, nullptr, XB1, XB0, mod1 + 2048, HB, a.in[8] + D, mod1 + 4096, rsq}; GEMM(EpiR1, YB, ws + WS_WOC, 1024, 1024, E); }
    SEAM(13);
    if (IN(15)) { pg8::EpiSwiglu E{PB, FF, rsq, shw + NCOND * (NGU + NC), NGU}; GEMM(pg8::EpiSwiglu, HB, ws + WS_WGU + (size_t)NGU * 1024 * 2, NGU, 1024, E); }
    SEAM(15);
    if (IN(16)) { EpiR2 E{nullptr, nullptr, XB0, HB, mod1 + 5120, nullptr, nullptr, nullptr, nullptr};
    GEMM(EpiR2, PB, ws + WS_WDN + (size_t)1024 * FF * 2, 1024, FF, E); }
    SEAM(16);
    if (IN(17)) final_norm_direct(HB, 0, a.out, a.in[23], 0, M, lane, wave);
#undef IN
#undef STAGGER
#undef SEAM
#undef GEMM
}

extern "C" void kernel_launch(void* const* d_in, const int* in_sizes, int n_in, void* d_out, int out_size, void* d_ws, size_t ws_size, hipStream_t stream) {
    static int grid = 0;
    if (grid == 0) {
        if (n_in != 24 || ws_size < WS_END) { fprintf(stderr, "kernel_launch: unexpected n_in %d / ws_size %zu\n", n_in, ws_size); grid = -1; return; }
        int dev = 0, cus = 0;
        if (hipGetDevice(&dev) != hipSuccess || hipDeviceGetAttribute(&cus, hipDeviceAttributeMultiprocessorCount, dev) != hipSuccess) { grid = -1; return; }
        if (hipFuncSetAttribute((const void*)mega_fwd, hipFuncAttributeMaxDynamicSharedMemorySize, LDS_BYTES) != hipSuccess) { fprintf(stderr, "kernel_launch: hipFuncSetAttribute failed\n"); grid = -1; return; }
        (void)hipGetLastError();
        grid = cus;
    }
    if (grid < 0) return;
    Args a{};
    for (int i = 0; i < 24; ++i) a.in[i] = (const float*)d_in[i];
    a.out = (float*)d_out; a.ws = (unsigned char*)d_ws;
#if ONE_LAUNCH
    if (hipMemsetAsync((char*)d_ws + WS_BAR, 0, XCD_BAR_WORDS * 4, stream) != hipSuccess) { fprintf(stderr, "kernel_launch: hipMemsetAsync failed\n"); return; }
    a.ph_lo = 0; a.ph_hi = N_PHASES;
    void* args[] = {&a};
    hipError_t e = hipLaunchCooperativeKernel((const void*)mega_fwd, dim3(grid), dim3(NTHREADS), args, LDS_BYTES, stream);
    if (e != hipSuccess) fprintf(stderr, "cooperative launch failed: %s (grid %d)\n", hipGetErrorString(e), grid);
#else
    for (int p = 0; p < N_PHASES; ++p) { a.ph_lo = p; a.ph_hi = p + 1; hipLaunchKernelGGL(mega_fwd, dim3(grid), dim3(NTHREADS), LDS_BYTES, stream, a); }
#endif
}
```
